# Optimizing an MI355X kernel written in HIP

```python
import jax, jax.numpy as jnp
from jax import lax
import numpy as np

D_MODEL = 1024
BATCH = 16
SEQ = 2048
DEPTH = 1

D_FF = 2816
MLSTM_HEADS = 4
MLSTM_QK_DIM = 64
MLSTM_V_DIM = 128
MLSTM_CHUNK = 64
GATE_SOFTCAP = 15.0
ATTN_Q_HEADS = 8
ATTN_KV_HEADS = 2
ATTN_HEAD_DIM = 64
WINDOW = 128
ROPE_DIM = ATTN_HEAD_DIM // 4
ROPE_THETA = 500000.0
NORM_EPS = 1e-6

MLSTM_QK_W = MLSTM_HEADS * MLSTM_QK_DIM
MLSTM_V_W = MLSTM_HEADS * MLSTM_V_DIM
ATTN_Q_W = ATTN_Q_HEADS * ATTN_HEAD_DIM
ATTN_KV_W = ATTN_KV_HEADS * ATTN_HEAD_DIM
IN_WIDTHS = (MLSTM_QK_W, MLSTM_QK_W, MLSTM_V_W, MLSTM_V_W, MLSTM_HEADS, MLSTM_HEADS,
             ATTN_Q_W, ATTN_KV_W, ATTN_KV_W, D_MODEL, D_MODEL)
IN_WIDTH = sum(IN_WIDTHS)

kernel_name = 'hybrid_mlstm_swa_sinks_macaron'


def _rmsnorm(x, g):
    xf = x.astype(jnp.float32)
    y = xf * lax.rsqrt(jnp.mean(xf * xf, axis=-1, keepdims=True) + NORM_EPS)
    return (y * g.astype(jnp.float32)).astype(x.dtype)


def _swiglu(h, w_gate, w_up, w_down):
    return (jax.nn.silu(h @ w_gate) * (h @ w_up)) @ w_down


def _split_cols(a, widths):
    out = []
    start = 0
    for w in widths:
        out.append(a[..., start:start + w])
        start += w
    return out


def _softcap(a):
    return GATE_SOFTCAP * jnp.tanh(a / GATE_SOFTCAP)


def _partial_rope(x, positions):
    half = ROPE_DIM // 2
    inv = ROPE_THETA ** (-jnp.arange(half, dtype=jnp.float32) * 2.0 / ROPE_DIM)
    ang = positions.astype(jnp.float32)[:, None, :, None] * inv
    cos, sin = jnp.cos(ang), jnp.sin(ang)
    xr = x[..., :ROPE_DIM].astype(jnp.float32)
    x1, x2 = xr[..., :half], xr[..., half:]
    rot = jnp.concatenate([x1 * cos - x2 * sin, x2 * cos + x1 * sin], axis=-1).astype(x.dtype)
    return jnp.concatenate([rot, x[..., ROPE_DIM:]], axis=-1)


def _mlstm(q, k, v, i_pre, f_pre):
    B, H, S, dk = q.shape
    dv = v.shape[-1]
    L = MLSTM_CHUNK
    NC = S // L
    q = q * (dk ** -0.5)
    logf = jax.nn.log_sigmoid(f_pre)
    rs = lambda a: a.reshape((B, H, NC, L) + a.shape[3:])
    qc, kc, vc, ic = rs(q), rs(k), rs(v), rs(i_pre)
    b = jnp.cumsum(rs(logf), axis=-1)
    b_last = b[..., -1]
    a = b_last[..., None] - b + ic

    def step(carry, inp):
        C, n, m = carry
        k_c, v_c, a_c, bl = inp
        m_new = jnp.maximum(bl + m, jnp.max(a_c, axis=-1))
        decay = jnp.exp(bl + m - m_new)
        w = jnp.exp(a_c - m_new[..., None])
        C_new = decay[..., None, None] * C + jnp.einsum('bhl,bhlv,bhlk->bhvk', w, v_c, k_c)
        n_new = decay[..., None] * n + jnp.einsum('bhl,bhlk->bhk', w, k_c)
        return (C_new, n_new, m_new), (C, n, m)

    init = (jnp.zeros((B, H, dv, dk), jnp.float32), jnp.zeros((B, H, dk), jnp.float32),
            jnp.zeros((B, H), jnp.float32))
    mv = lambda t: jnp.moveaxis(t, 2, 0)
    _, (C_prev, n_prev, m_prev) = lax.scan(step, init, (mv(kc), mv(vc), mv(a), mv(b_last)))
    C_prev = jnp.moveaxis(C_prev, 0, 2)
    n_prev = jnp.moveaxis(n_prev, 0, 2)
    m_prev = jnp.moveaxis(m_prev, 0, 2)

    causal = jnp.tril(jnp.ones((L, L), dtype=bool))
    logD = b[..., :, None] - b[..., None, :] + ic[..., None, :]
    logD = jnp.where(causal, logD, -jnp.inf)
    inter_log = b + m_prev[..., None]
    m = jnp.maximum(inter_log, jnp.max(logD, axis=-1))
    sqk = jnp.einsum('bhcjk,bhcsk->bhcjs', qc, kc) * jnp.exp(logD - m[..., None])
    inter_scale = jnp.exp(inter_log - m)
    num = (jnp.einsum('bhcjs,bhcsv->bhcjv', sqk, vc)
           + inter_scale[..., None] * jnp.einsum('bhcjk,bhcvk->bhcjv', qc, C_prev))
    den = jnp.sum(sqk, axis=-1) + inter_scale * jnp.einsum('bhcjk,bhck->bhcj', qc, n_prev)
    h = num / jnp.maximum(jnp.abs(den), jnp.exp(-m))[..., None]
    return h.reshape(B, H, S, dv)


def _swa_sinks(q, k, v, sinks):
    B, Hq, S, hd = q.shape
    Hkv = k.shape[1]
    G = Hq // Hkv
    W = WINDOW
    NB = S // W
    qb = q.reshape(B, Hkv, G, NB, W, hd) * (hd ** -0.5)
    pad = lambda t: jnp.pad(t, ((0, 0), (0, 0), (W, 0), (0, 0))).reshape(B, Hkv, NB + 1, W, hd)
    kp, vp = pad(k), pad(v)
    kb = jnp.concatenate([kp[:, :, :-1], kp[:, :, 1:]], axis=3)
    vb = jnp.concatenate([vp[:, :, :-1], vp[:, :, 1:]], axis=3)
    s = jnp.einsum('bkgnqd,bknsd->bkgnqs', qb, kb).astype(jnp.float32)
    qi = jnp.arange(W)[:, None]
    si = jnp.arange(2 * W)[None, :]
    band = (si > qi) & (si <= qi + W)
    valid = (jnp.arange(NB)[:, None, None] > 0) | (si[None] >= W)
    s = jnp.where(band[None] & valid, s, -jnp.inf)
    sink = jnp.broadcast_to(sinks.astype(jnp.float32).reshape(1, Hkv, G, 1, 1, 1),
                            s.shape[:-1] + (1,))
    p = jax.nn.softmax(jnp.concatenate([s, sink], axis=-1), axis=-1)[..., :-1]
    o = jnp.einsum('bkgnqs,bknsd->bkgnqd', p.astype(vb.dtype), vb)
    return o.reshape(B, Hq, S, hd)


def _mixer(h, positions, w_in, b_i, b_f, out_norm_g, sinks, w_br_m, w_br_a, w_out):
    B, S, _ = h.shape
    proj = h @ w_in
    q_m, k_m, v_m, o_m, i_m, f_m, q_a, k_a, v_a, g_m, g_a = _split_cols(proj, IN_WIDTHS)
    heads = lambda t, n: t.reshape(B, S, n, -1).transpose(0, 2, 1, 3)
    f32 = jnp.float32
    i_pre = _softcap((i_m + b_i).astype(f32)).transpose(0, 2, 1)
    f_pre = _softcap((f_m + b_f).astype(f32)).transpose(0, 2, 1)
    hm = _mlstm(heads(q_m, MLSTM_HEADS).astype(f32), heads(k_m, MLSTM_HEADS).astype(f32),
                heads(v_m, MLSTM_HEADS).astype(f32), i_pre, f_pre)
    hm = hm * lax.rsqrt(jnp.mean(hm * hm, axis=-1, keepdims=True) + NORM_EPS)
    hm = hm * out_norm_g.astype(f32).reshape(MLSTM_HEADS, 1, MLSTM_V_DIM)
    hm = hm.transpose(0, 2, 1, 3).reshape(B, S, MLSTM_V_W) * jax.nn.sigmoid(o_m.astype(f32))
    y_m = hm.astype(h.dtype) @ w_br_m
    qa = _partial_rope(heads(q_a, ATTN_Q_HEADS), positions)
    ka = _partial_rope(heads(k_a, ATTN_KV_HEADS), positions)
    va = heads(v_a, ATTN_KV_HEADS)
    oa = _swa_sinks(qa, ka, va, sinks).transpose(0, 2, 1, 3).reshape(B, S, ATTN_Q_W)
    y_a = oa @ w_br_a
    merged = jax.nn.sigmoid(g_m) * y_m + jax.nn.sigmoid(g_a) * y_a
    return merged @ w_out


def setup_inputs(seed: int = 0) -> dict:
    key = jax.random.key(seed)
    ks = jax.random.split(key, 24)
    nrm = lambda k, shape, fan_in: jax.random.normal(k, shape, jnp.float32) * (fan_in ** -0.5)
    gain = lambda k, n: 1.0 + 0.02 * jax.random.normal(k, (DEPTH, n), jnp.float32)
    x = jax.random.normal(ks[0], (BATCH, SEQ, D_MODEL), jnp.float32)
    start = jax.random.randint(ks[1], (BATCH, 1), 0, 4096, dtype=jnp.int32)
    positions = start + jnp.arange(SEQ, dtype=jnp.int32)[None, :]
    return {
        'x': x,
        'positions': positions,
        'ffn1_norm_g': gain(ks[2], D_MODEL),
        'ffn1_w_gate': nrm(ks[3], (DEPTH, D_MODEL, D_FF), D_MODEL),
        'ffn1_w_up': nrm(ks[4], (DEPTH, D_MODEL, D_FF), D_MODEL),
        'ffn1_w_down': nrm(ks[5], (DEPTH, D_FF, D_MODEL), D_FF),
        'mix_norm_g': gain(ks[6], D_MODEL),
        'w_in': nrm(ks[7], (DEPTH, D_MODEL, IN_WIDTH), D_MODEL),
        'mlstm_b_i': 0.1 * jax.random.normal(ks[8], (DEPTH, MLSTM_HEADS), jnp.float32),
        'mlstm_b_f': 3.0 + 0.5 * jax.random.normal(ks[9], (DEPTH, MLSTM_HEADS), jnp.float32),
        'mlstm_out_norm_g': gain(ks[10], MLSTM_V_W),
        'attn_sinks': 0.5 * jax.random.normal(ks[11], (DEPTH, ATTN_Q_HEADS), jnp.float32),
        'w_branch_mlstm': nrm(ks[12], (DEPTH, MLSTM_V_W, D_MODEL), MLSTM_V_W),
        'w_branch_attn': nrm(ks[13], (DEPTH, ATTN_Q_W, D_MODEL), ATTN_Q_W),
        'w_out': nrm(ks[14], (DEPTH, D_MODEL, D_MODEL), D_MODEL),
        'ffn2_norm_g': gain(ks[15], D_MODEL),
        'ffn2_w_gate': nrm(ks[16], (DEPTH, D_MODEL, D_FF), D_MODEL),
        'ffn2_w_up': nrm(ks[17], (DEPTH, D_MODEL, D_FF), D_MODEL),
        'ffn2_w_down': nrm(ks[18], (DEPTH, D_FF, D_MODEL), D_FF),
        'final_norm_g': 1.0 + 0.02 * jax.random.normal(ks[19], (D_MODEL,), jnp.float32),
    }


def reference(x, positions, ffn1_norm_g, ffn1_w_gate, ffn1_w_up, ffn1_w_down, mix_norm_g,
              w_in, mlstm_b_i, mlstm_b_f, mlstm_out_norm_g, attn_sinks, w_branch_mlstm,
              w_branch_attn, w_out, ffn2_norm_g, ffn2_w_gate, ffn2_w_up, ffn2_w_down,
              final_norm_g):
    for l in range(DEPTH):
        h = _rmsnorm(x, ffn1_norm_g[l])
        x = x + 0.5 * _swiglu(h, ffn1_w_gate[l], ffn1_w_up[l], ffn1_w_down[l])
        h = _rmsnorm(x, mix_norm_g[l])
        x = x + _mixer(h, positions, w_in[l], mlstm_b_i[l], mlstm_b_f[l], mlstm_out_norm_g[l],
                       attn_sinks[l], w_branch_mlstm[l], w_branch_attn[l], w_out[l])
        h = _rmsnorm(x, ffn2_norm_g[l])
        x = x + 0.5 * _swiglu(h, ffn2_w_gate[l], ffn2_w_up[l], ffn2_w_down[l])
    return _rmsnorm(x, final_norm_g)
```

```cpp
#include <hip/hip_runtime.h>
#include <hip/hip_cooperative_groups.h>
#include <cstdio>
#include <cstdint>
namespace cg = cooperative_groups;

#define LAS __attribute__((address_space(3)))
typedef unsigned short bf16_t;
typedef short bf16x8 __attribute__((ext_vector_type(8)));
typedef float f32x4 __attribute__((ext_vector_type(4)));
typedef float f32x2 __attribute__((ext_vector_type(2)));
typedef unsigned u32x4 __attribute__((ext_vector_type(4)));
typedef unsigned u32x2 __attribute__((ext_vector_type(2)));

constexpr int BATCH = 16, SEQ = 2048, DM = 1024, M = BATCH * SEQ, DFF = 2816, NGU = 2 * DFF;
constexpr int NIN = 4608;
constexpr int WIN_SRC = 4360;
constexpr int PC_QM = 0, PC_KM = 256, PC_VM = 512, PC_OM = 1024, PC_QA = 1536, PC_KA = 2048, PC_VA = 2176, PC_GM = 2304, PC_GA = 3328;
constexpr float NORM_EPS = 1e-6f;
constexpr int NWAVES = 8;

constexpr size_t MiB = 1u << 20;
constexpr size_t WS_CTL = 0, CTL_USED_BYTES = 64 * 1024 + 4 * 131072;
constexpr size_t WS_PCNT = 16 * 1024;
constexpr size_t WS_XL = 50 * 1024;
constexpr size_t WS_SS = 64 * 1024;
constexpr size_t WS_W1GU = 1 * MiB, WS_W1D = 12 * MiB, WS_WIN = 18 * MiB, WS_WBR = 27 * MiB, WS_WO = 29 * MiB, WS_W2GU = 31 * MiB, WS_W2D = 42 * MiB;
constexpr size_t WS_GATES = 48 * MiB;
constexpr size_t WS_ROPE = 49 * MiB;
constexpr size_t WS_XB = 56 * MiB;
constexpr size_t WS_ACT = 120 * MiB;
constexpr size_t WS_HO = 408 * MiB;
constexpr size_t WS_CG = 472 * MiB;
constexpr size_t WS_NG = 480 * MiB;
constexpr size_t WS_SG = WS_NG + 64 * 4 * 64 * 4;
constexpr size_t WS_CHS = WS_SG + 64 * 4 * 2 * 4;
constexpr size_t WS_END = 481 * MiB;

constexpr int RING_BYTES = 131072;
constexpr int LDS_BYTES = 147456;
constexpr int LDS_BARW = LDS_BYTES - 64;

__device__ __forceinline__ unsigned cvt_pk_bf16(float lo, float hi) { unsigned r; asm volatile("v_cvt_pk_bf16_f32 %0, %1, %2" : "=v"(r) : "v"(lo), "v"(hi)); return r; }
__device__ __forceinline__ bf16_t f2bf(float f) { return (bf16_t)(cvt_pk_bf16(f, 0.f) & 0xffffu); }
__device__ __forceinline__ float bf2f(unsigned short h) { return __uint_as_float(((unsigned)h) << 16); }
__device__ __forceinline__ float bflo(unsigned w) { return __uint_as_float(w << 16); }
__device__ __forceinline__ float bfhi(unsigned w) { return __uint_as_float(w & 0xffff0000u); }
__device__ __forceinline__ float sigm(float x) { return __builtin_amdgcn_rcpf(1.f + __expf(-x)); }
__device__ __forceinline__ float wave_sum(float v) {
#pragma unroll
    for (int o = 1; o < 64; o <<= 1) v += __shfl_xor(v, o);
    return v;
}
#define LDS_WAIT() asm volatile("s_waitcnt lgkmcnt(0)" ::: "memory")

namespace pg8 {
constexpr int BM = 256, BK = 64, HALF = 128, HTB = HALF * BK * 2, STAGE_BYTES = 8 * HTB, NXCD = 8, WGM = 4;
__host__ __device__ __forceinline__ int lds_byte(int r, int c) { const int st = (r >> 4) * 2 + (c >> 5), rr = r & 15, cc = c & 31, ob = rr * 64 + cc * 2; return st * 1024 + (ob ^ (((ob >> 9) & 1) << 5)); }
__host__ __device__ __forceinline__ void stage_rc(int b, int& R, int& C) { const int st = b / 1024, sb = b % 1024, swz = sb ^ (((sb >> 9) & 1) << 5); R = (st >> 1) * 16 + swz / 64; C = (st & 1) * 32 + (swz % 64) / 2; }
__host__ __device__ __forceinline__ int perm32(int rho) { const int n = rho >> 4, i = rho & 15; return 8 * (i >> 2) + 4 * n + (i & 3); }

struct Unit { int pm, pn, idx; };
struct Gemm { const bf16_t* A; const bf16_t* Bt; int lda, ldb, K; };

struct StaticOrder {
    int nM, nN, nwg, G, c;
    __host__ __device__ void init(int M_, int N_, int G_, int c_) { nM = M_ / BM; nN = N_ / BM; nwg = nM * nN; G = G_; c = c_; }
    __host__ __device__ bool next(int i, Unit& u) const {
        const long L = (long)i * G + c; if (L >= nwg) return false;
        int wgid = (int)L; { const int q = nwg / NXCD, r = nwg % NXCD, xcd = wgid % NXCD, off = wgid / NXCD; wgid = (xcd < r ? xcd * (q + 1) : r * (q + 1) + (xcd - r) * q) + off; }
        const int nig = WGM * nN, gid = wgid / nig, fm = gid * WGM, gsz = (nM - fm) < WGM ? (nM - fm) : WGM;
        u.pm = fm + ((wgid % nig) % gsz); u.pn = (wgid % nig) / gsz; u.idx = i; return true;
    }
};

typedef f32x4 Acc[2][2][4][2];

struct EpiSwiGLU {
    static constexpr int MID_T = -1;
    bf16_t* O; const LAS float* rs;
    __device__ __forceinline__ void mid(Acc&, const Unit&, int, int, int, int) const {}
    __device__ __forceinline__ void operator()(Acc& acc, const Unit& u, int wr, int wc, int fr, int fq) const {
        const int row0 = u.pm * BM + wr * 64 + fr, col0 = u.pn * 128 + wc * 32 + 8 * fq;
#pragma unroll
        for (int ai = 0; ai < 2; ++ai)
#pragma unroll
            for (int m = 0; m < 4; ++m) {
                const int row = row0 + ai * HALF + m * 16;
                const float r = rs[u.idx * BM + wr * 64 + fr + ai * HALF + m * 16];
                const float c1 = -r * 1.4426950408889634f, r2 = r * r;
                f32x4 o[2];
#pragma unroll
                for (int n = 0; n < 2; ++n) {
                    const f32x4 g = acc[ai][0][m][n], up = acc[ai][1][m][n];
                    const f32x4 t = g * c1; f32x4 e;
#pragma unroll
                    for (int i = 0; i < 4; ++i) e[i] = __builtin_amdgcn_exp2f(t[i]);
                    const f32x4 d = e + 1.0f; f32x4 q;
#pragma unroll
                    for (int i = 0; i < 4; ++i) q[i] = __builtin_amdgcn_rcpf(d[i]);
                    o[n] = (g * up) * (q * r2);
                }
                u32x4 w; w.x = cvt_pk_bf16(o[0][0], o[0][1]); w.y = cvt_pk_bf16(o[0][2], o[0][3]); w.z = cvt_pk_bf16(o[1][0], o[1][1]); w.w = cvt_pk_bf16(o[1][2], o[1][3]);
                *(u32x4*)(O + (size_t)row * DFF + col0) = w;
            }
    }
};
template <bool BASE_BF16> struct EpiResid {
    static constexpr int MID_T = -1;
    const void* base; bf16_t* xb; float* ss; float scale;
    __device__ __forceinline__ void mid(Acc&, const Unit&, int, int, int, int) const {}
    __device__ __forceinline__ void operator()(Acc& acc, const Unit& u, int wr, int wc, int fr, int fq) const {
        const int row0 = u.pm * BM + wr * 64 + fr, col0 = u.pn * BM + wc * 32 + 8 * fq;
#pragma unroll
        for (int ai = 0; ai < 2; ++ai)
#pragma unroll
            for (int m = 0; m < 4; ++m) {
                const int row = row0 + ai * HALF + m * 16; float sq = 0.f;
#pragma unroll
                for (int bj = 0; bj < 2; ++bj) {
                    const size_t p = (size_t)row * DM + col0 + bj * HALF;
                    f32x4 b0, b1;
                    if constexpr (BASE_BF16) { const u32x4 w = *(const u32x4*)((const bf16_t*)base + p); b0 = (f32x4){bflo(w.x), bfhi(w.x), bflo(w.y), bfhi(w.y)}; b1 = (f32x4){bflo(w.z), bfhi(w.z), bflo(w.w), bfhi(w.w)}; }
                    else { b0 = *(const f32x4*)((const float*)base + p); b1 = *(const f32x4*)((const float*)base + p + 4); }
                    const f32x4 v0 = b0 + acc[ai][bj][m][0] * scale, v1 = b1 + acc[ai][bj][m][1] * scale;
                    u32x4 w; w.x = cvt_pk_bf16(v0[0], v0[1]); w.y = cvt_pk_bf16(v0[2], v0[3]); w.z = cvt_pk_bf16(v1[0], v1[1]); w.w = cvt_pk_bf16(v1[2], v1[3]); *(u32x4*)(xb + p) = w;
                    sq += (v0[0] * v0[0] + v0[1] * v0[1]) + (v0[2] * v0[2] + v0[3] * v0[3]) + (v1[0] * v1[0] + v1[1] * v1[1]) + (v1[2] * v1[2] + v1[3] * v1[3]);
                }
                sq += __shfl_xor(sq, 16); sq += __shfl_xor(sq, 32);
                if (fq == 0) atomicAdd(ss + row, sq);
            }
    }
};
struct EpiFinal {
    static constexpr int MID_T = -1;
    const bf16_t* base; float* out; float* ss; unsigned* cnt; const float* gain; float scale;
    __device__ __forceinline__ void mid(Acc&, const Unit&, int, int, int, int) const {}
    __device__ __forceinline__ void operator()(Acc& acc, const Unit& u, int wr, int wc, int fr, int fq) const {
        const int row0 = u.pm * BM + wr * 64 + fr, col0 = u.pn * BM + wc * 32 + 8 * fq;
#pragma unroll
        for (int ai = 0; ai < 2; ++ai)
#pragma unroll
            for (int m = 0; m < 4; ++m) {
                const int row = row0 + ai * HALF + m * 16; float sq = 0.f;
#pragma unroll
                for (int bj = 0; bj < 2; ++bj) {
                    const size_t p = (size_t)row * DM + col0 + bj * HALF;
                    const u32x4 w = *(const u32x4*)(base + p);
                    const f32x4 v0 = (f32x4){bflo(w.x), bfhi(w.x), bflo(w.y), bfhi(w.y)} + acc[ai][bj][m][0] * scale, v1 = (f32x4){bflo(w.z), bfhi(w.z), bflo(w.w), bfhi(w.w)} + acc[ai][bj][m][1] * scale;
                    acc[ai][bj][m][0] = v0; acc[ai][bj][m][1] = v1;
                    sq += (v0[0] * v0[0] + v0[1] * v0[1]) + (v0[2] * v0[2] + v0[3] * v0[3]) + (v1[0] * v1[0] + v1[1] * v1[1]) + (v1[2] * v1[2] + v1[3] * v1[3]);
                }
                sq += __shfl_xor(sq, 16); sq += __shfl_xor(sq, 32);
                if (fq == 0) atomicAdd(ss + row, sq);
            }
        asm volatile("s_waitcnt vmcnt(0)" ::: "memory");
        unsigned* c = cnt + 64 * u.pm;
        if ((threadIdx.x & 63) == 0) __hip_atomic_fetch_add(c, 1u, __ATOMIC_RELAXED, __HIP_MEMORY_SCOPE_AGENT);
        { unsigned sp = 0; while (__hip_atomic_load(c, __ATOMIC_RELAXED, __HIP_MEMORY_SCOPE_AGENT) < 32u) { __builtin_amdgcn_s_sleep(2); if (++sp > (1u << 22)) break; } }
        asm volatile("" ::: "memory");
        const f32x4 g00 = *(const f32x4*)(gain + col0), g01 = *(const f32x4*)(gain + col0 + 4), g10 = *(const f32x4*)(gain + col0 + HALF), g11 = *(const f32x4*)(gain + col0 + HALF + 4);
#pragma unroll
        for (int ai = 0; ai < 2; ++ai)
#pragma unroll
            for (int m = 0; m < 4; ++m) {
                const int row = row0 + ai * HALF + m * 16;
                const float r = rsqrtf(__hip_atomic_load(ss + row, __ATOMIC_RELAXED, __HIP_MEMORY_SCOPE_AGENT) * (1.0f / DM) + NORM_EPS);
                float* op = out + (size_t)row * DM + col0;
                *(f32x4*)op = acc[ai][0][m][0] * r * g00; *(f32x4*)(op + 4) = acc[ai][0][m][1] * r * g01;
                *(f32x4*)(op + HALF) = acc[ai][1][m][0] * r * g10; *(f32x4*)(op + HALF + 4) = acc[ai][1][m][1] * r * g11;
            }
    }
};
struct EpiInProj {
    static constexpr int MID_T = -1;
    bf16_t* P; float* gates; const LAS float* rs;
    __device__ __forceinline__ void mid(Acc&, const Unit&, int, int, int, int) const {}
    __device__ __forceinline__ void operator()(Acc& acc, const Unit& u, int wr, int wc, int fr, int fq) const {
        const int row0 = u.pm * BM + wr * 64 + fr, col0 = u.pn * BM + wc * 32 + 8 * fq;
        const bool gate_tile = (u.pn == 17);
#pragma unroll
        for (int ai = 0; ai < 2; ++ai)
#pragma unroll
            for (int m = 0; m < 4; ++m) {
                const int row = row0 + ai * HALF + m * 16;
                const float r = rs[u.idx * BM + wr * 64 + fr + ai * HALF + m * 16];
                if (gate_tile) {
                    if (wc == 0 && fq == 0) { *(f32x4*)(gates + (size_t)row * 8) = acc[ai][0][m][0] * r; *(f32x4*)(gates + (size_t)row * 8 + 4) = acc[ai][0][m][1] * r; }
                } else if (u.pn >= 9) {
                    const float c1 = -r * 1.4426950408889634f;
                    f32x4 R[2], S[2];
#pragma unroll
                    for (int n = 0; n < 2; ++n) {
                        const f32x4 tm = acc[ai][0][m][n] * c1, ta = acc[ai][1][m][n] * c1; f32x4 em, ea;
#pragma unroll
                        for (int i = 0; i < 4; ++i) { em[i] = __builtin_amdgcn_exp2f(tm[i]); ea[i] = __builtin_amdgcn_exp2f(ta[i]); }
                        const f32x4 dm = em + 1.0f, da = ea + 1.0f; f32x4 qm, qa;
#pragma unroll
                        for (int i = 0; i < 4; ++i) { qm[i] = __builtin_amdgcn_rcpf(dm[i]); qa[i] = __builtin_amdgcn_rcpf(da[i]); }
                        R[n] = da * qm; S[n] = qa;
                    }
                    const int gcol = (u.pn - 9) * HALF + wc * 32 + 8 * fq;
                    u32x4 w; w.x = cvt_pk_bf16(R[0][0], R[0][1]); w.y = cvt_pk_bf16(R[0][2], R[0][3]); w.z = cvt_pk_bf16(R[1][0], R[1][1]); w.w = cvt_pk_bf16(R[1][2], R[1][3]);
                    *(u32x4*)(P + (size_t)row * NIN + PC_GM + gcol) = w;
                    w.x = cvt_pk_bf16(S[0][0], S[0][1]); w.y = cvt_pk_bf16(S[0][2], S[0][3]); w.z = cvt_pk_bf16(S[1][0], S[1][1]); w.w = cvt_pk_bf16(S[1][2], S[1][3]);
                    *(u32x4*)(P + (size_t)row * NIN + PC_GA + gcol) = w;
                } else {
#pragma unroll
                    for (int bj = 0; bj < 2; ++bj) {
                        const f32x4 v0 = acc[ai][bj][m][0] * r, v1 = acc[ai][bj][m][1] * r;
                        u32x4 w; w.x = cvt_pk_bf16(v0[0], v0[1]); w.y = cvt_pk_bf16(v0[2], v0[3]); w.z = cvt_pk_bf16(v1[0], v1[1]); w.w = cvt_pk_bf16(v1[2], v1[3]);
                        *(u32x4*)(P + (size_t)row * NIN + col0 + bj * HALF) = w;
                    }
                }
            }
    }
};
struct EpiMerge {
    static constexpr int MID_T = 8;
    const bf16_t* P; bf16_t* O; int ldo;
    __device__ __forceinline__ void scale(Acc& acc, const Unit& u, int wr, int wc, int fr, int fq, int pc, bool store) const {
        int row0 = u.pm * BM + wr * 64 + fr, col0 = u.pn * BM + wc * 32 + 8 * fq;
        asm volatile("" : "+v"(row0), "+v"(col0));
        const char* Pb = (const char*)P; char* Ob = (char*)O;
#pragma unroll
        for (int ai = 0; ai < 2; ++ai) {
            u32x4 g[4][2];
#pragma unroll
            for (int m = 0; m < 4; ++m) {
                const unsigned rowoff = (unsigned)(row0 + ai * HALF + m * 16) * (unsigned)(NIN * 2) + (unsigned)col0 * 2u;
#pragma unroll
                for (int bj = 0; bj < 2; ++bj) g[m][bj] = *(const u32x4*)(Pb + (rowoff + (unsigned)((pc + bj * HALF) * 2)));
            }
#pragma unroll
            for (int m = 0; m < 4; ++m) {
                const unsigned ooff = (unsigned)(row0 + ai * HALF + m * 16) * (unsigned)(ldo * 2) + (unsigned)col0 * 2u;
#pragma unroll
                for (int bj = 0; bj < 2; ++bj) {
                    const u32x4 gg = g[m][bj];
                    const f32x4 s0 = (f32x4){bflo(gg.x), bfhi(gg.x), bflo(gg.y), bfhi(gg.y)}, s1 = (f32x4){bflo(gg.z), bfhi(gg.z), bflo(gg.w), bfhi(gg.w)};
                    const f32x4 v0 = acc[ai][bj][m][0] * s0, v1 = acc[ai][bj][m][1] * s1;
                    if (store) { u32x4 w; w.x = cvt_pk_bf16(v0[0], v0[1]); w.y = cvt_pk_bf16(v0[2], v0[3]); w.z = cvt_pk_bf16(v1[0], v1[1]); w.w = cvt_pk_bf16(v1[2], v1[3]); *(u32x4*)(Ob + (ooff + (unsigned)(bj * HALF * 2))) = w; }
                    else { acc[ai][bj][m][0] = v0; acc[ai][bj][m][1] = v1; }
                }
            }
            asm volatile("" ::: "memory");
        }
    }
    __device__ __forceinline__ void mid(Acc& acc, const Unit& u, int wr, int wc, int fr, int fq) const { scale(acc, u, wr, wc, fr, fq, PC_GM, false); }
    __device__ __forceinline__ void operator()(Acc& acc, const Unit& u, int wr, int wc, int fr, int fq) const { scale(acc, u, wr, wc, fr, fq, PC_GA, true); }
};

template <class Sched>
__device__ __forceinline__ void rstd_table(LAS float* rs, const float* ss, const Sched& S) {
    Unit u;
    for (int i = 0; i < 15 && S.next(i, u); ++i) if (threadIdx.x < BM) rs[i * BM + threadIdx.x] = rsqrtf(ss[u.pm * BM + threadIdx.x] * (1.0f / DM) + NORM_EPS);
}
template <class Epi, class Sched, bool ALIGN_EPI>
__device__ __forceinline__ void gemm_phase(LAS unsigned char* lds, const Gemm g, const Sched& S, const Epi& E, const float* pre_ss = nullptr, LAS float* pre_rs = nullptr) {
    const int tid = threadIdx.x, wid = __builtin_amdgcn_readfirstlane(tid >> 6), lane = tid & 63, wr = wid >> 2, wc = wid & 3, fr = lane & 15, fq = lane >> 4;
    const int K = g.K, nt = K / BK;
    unsigned voffA[2], voffB[2];
#pragma unroll
    for (int i = 0; i < 2; ++i) { int R, C; stage_rc(tid * 16 + i * 8192, R, C); const int Rb = (R & ~31) + perm32(R & 31);
        voffA[i] = (unsigned)(R * g.lda + C) * 2u; voffB[i] = (unsigned)(Rb * g.ldb + C) * 2u; }
    const size_t kstep = (size_t)(BK * 2);
    const size_t hstepA = (size_t)HALF * g.lda * 2, hstepB = (size_t)HALF * g.ldb * 2;
    const size_t tstepA = 2 * hstepA, tstepB = 2 * hstepB;
    const unsigned ldsw = (unsigned)wid * 1024u;
    const int aoff = lds_byte(wr * 64 + fr, fq * 8), boff = lds_byte(wc * 32 + fr, fq * 8);
#define PG8_SA(b, h) (((b) * 2 + (h)) * HTB)
#define PG8_SB(b, h) ((4 + (b) * 2 + (h)) * HTB)
#define PG8_STAGE(bufoff, gbase, voff) do { _Pragma("unroll") for (int _i = 0; _i < 2; ++_i) \
        __builtin_amdgcn_global_load_lds((const unsigned*)((const char*)(gbase) + (voff)[_i]), (LAS unsigned*)(lds + (bufoff) + ldsw + _i * 8192), 16, 0, 0); } while (0)
#define PG8_LDA(dst, b, h) do { _Pragma("unroll") for (int m = 0; m < 4; ++m) _Pragma("unroll") for (int k = 0; k < 2; ++k) dst[m][k] = *(const LAS bf16x8*)(lds + PG8_SA(b, h) + aoff + m * 2048 + k * 1024); } while (0)
#define PG8_LDB(dst, b, h) do { _Pragma("unroll") for (int n = 0; n < 2; ++n) _Pragma("unroll") for (int k = 0; k < 2; ++k) dst[n][k] = *(const LAS bf16x8*)(lds + PG8_SB(b, h) + boff + n * 2048 + k * 1024); } while (0)
#define PG8_MMA(ai, bj, At, Bt) do { __builtin_amdgcn_s_setprio(1); _Pragma("unroll") for (int m = 0; m < 4; ++m) _Pragma("unroll") for (int n = 0; n < 2; ++n) _Pragma("unroll") for (int k = 0; k < 2; ++k) \
        acc[ai][bj][m][n] = __builtin_amdgcn_mfma_f32_16x16x32_bf16(Bt[n][k], At[m][k], acc[ai][bj][m][n], 0, 0, 0); __builtin_amdgcn_s_setprio(0); } while (0)
#define PG8_WAIT_V(n) asm volatile("s_waitcnt vmcnt(" #n ")" ::: "memory")
#define PG8_WAIT_L(n) asm volatile("s_waitcnt lgkmcnt(" #n ")" ::: "memory")
#define PG8_BAR __builtin_amdgcn_s_barrier()
#define PG8_SCHED __builtin_amdgcn_sched_barrier(0)
#define PG8_KBODY(t) do { \
            const bool last = (t == nt - 2); \
            const char* a1 = cA + (size_t)(t + 1) * kstep; \
            const char* a2 = last ? nA : cA + (size_t)(t + 2) * kstep; const char* b2 = last ? nB : cB + (size_t)(t + 2) * kstep; \
            const char* a3 = a2 + kstep; const char* b3 = b2 + kstep; \
            PG8_LDB(B0, 0, 0); PG8_LDB(B1, 0, 1); PG8_SCHED; PG8_LDA(At, 0, 0); PG8_STAGE(PG8_SA(1, 1), a1 + hstepA, voffA); \
            PG8_WAIT_V(8); PG8_WAIT_L(0); PG8_BAR; PG8_MMA(0, 0, At, B0); PG8_MMA(0, 1, At, B1); PG8_BAR; PG8_SCHED; \
            PG8_LDA(At, 0, 1); PG8_STAGE(PG8_SB(0, 0), b2, voffB); PG8_STAGE(PG8_SB(0, 1), b2 + hstepB, voffB); PG8_STAGE(PG8_SA(0, 0), a2, voffA); \
            PG8_WAIT_V(8); PG8_WAIT_L(0); PG8_BAR; PG8_MMA(1, 0, At, B0); PG8_MMA(1, 1, At, B1); PG8_BAR; PG8_SCHED; \
            PG8_LDB(B0, 1, 0); PG8_LDB(B1, 1, 1); PG8_SCHED; PG8_LDA(At, 1, 0); PG8_STAGE(PG8_SA(0, 1), a2 + hstepA, voffA); \
            PG8_WAIT_V(8); PG8_WAIT_L(0); PG8_BAR; PG8_MMA(0, 0, At, B0); PG8_MMA(0, 1, At, B1); PG8_BAR; PG8_SCHED; \
            PG8_LDA(At, 1, 1); PG8_STAGE(PG8_SB(1, 0), b3, voffB); PG8_STAGE(PG8_SB(1, 1), b3 + hstepB, voffB); PG8_STAGE(PG8_SA(1, 0), a3, voffA); \
            PG8_WAIT_V(8); PG8_WAIT_L(0); PG8_BAR; PG8_MMA(1, 0, At, B0); PG8_MMA(1, 1, At, B1); PG8_BAR; PG8_SCHED; \
        } while (0)
    Unit cur, nxt; int ui = 0;
    if (!S.next(0, cur)) return;
    Acc acc;
#pragma unroll
    for (int a = 0; a < 2; ++a)
#pragma unroll
        for (int b = 0; b < 2; ++b)
#pragma unroll
            for (int m = 0; m < 4; ++m)
#pragma unroll
                for (int n = 0; n < 2; ++n) acc[a][b][m][n] = (f32x4){0.f, 0.f, 0.f, 0.f};
    bf16x8 At[4][2], B0[2][2], B1[2][2];
    const char* cA = (const char*)g.A + (size_t)cur.pm * tstepA; const char* cB = (const char*)g.Bt + (size_t)cur.pn * tstepB;
    PG8_STAGE(PG8_SB(0, 0), cB, voffB); PG8_STAGE(PG8_SB(0, 1), cB + hstepB, voffB); PG8_STAGE(PG8_SA(0, 0), cA, voffA); PG8_STAGE(PG8_SA(0, 1), cA + hstepA, voffA);
    if (pre_ss) rstd_table(pre_rs, pre_ss, S);
    if (wr == 1) PG8_BAR;
    PG8_WAIT_V(2); PG8_BAR;
    PG8_STAGE(PG8_SB(1, 0), cB + kstep, voffB); PG8_STAGE(PG8_SA(1, 0), cA + kstep, voffA); PG8_STAGE(PG8_SB(1, 1), cB + hstepB + kstep, voffB);
    PG8_WAIT_V(6); PG8_BAR;
    for (;;) {
        const bool has_next = S.next(ui + 1, nxt);
        const char* nA = has_next ? (const char*)g.A + (size_t)nxt.pm * tstepA : cA; const char* nB = has_next ? (const char*)g.Bt + (size_t)nxt.pn * tstepB : cB;
        if constexpr (Epi::MID_T >= 0) {
            for (int t = 0; t < Epi::MID_T; t += 2) PG8_KBODY(t);
            E.mid(acc, cur, wr, wc, fr, fq);
            for (int t = Epi::MID_T; t < nt; t += 2) PG8_KBODY(t);
        } else {
            for (int t = 0; t < nt; t += 2) PG8_KBODY(t);
        }
        if constexpr (ALIGN_EPI) { if (wr == 0) PG8_BAR; }
        E(acc, cur, wr, wc, fr, fq);
        if (!has_next) break;
#pragma unroll
        for (int a = 0; a < 2; ++a)
#pragma unroll
            for (int b = 0; b < 2; ++b)
#pragma unroll
                for (int m = 0; m < 4; ++m)
#pragma unroll
                    for (int n = 0; n < 2; ++n) acc[a][b][m][n] = (f32x4){0.f, 0.f, 0.f, 0.f};
        cur = nxt; cA = nA; cB = nB; ++ui;
        if constexpr (ALIGN_EPI) { if (wr == 1) PG8_BAR; }
    }
    PG8_WAIT_V(0);
    if constexpr (!ALIGN_EPI) { if (wr == 0) PG8_BAR; }
    PG8_BAR;
#undef PG8_SA
#undef PG8_SB
#undef PG8_STAGE
#undef PG8_LDA
#undef PG8_LDB
#undef PG8_MMA
#undef PG8_WAIT_V
#undef PG8_WAIT_L
#undef PG8_BAR
#undef PG8_SCHED
#undef PG8_KBODY
}
}

__device__ __forceinline__ void transpose_item(const float* colp, int N, const float* gk, bf16_t* WT, int ldw, int koff, int k0, int n0, LAS float* scr, int lane) {
    float v[32];
#pragma unroll
    for (int i = 0; i < 32; ++i) { const int kk = 2 * i + (lane >> 5); v[i] = colp ? colp[(size_t)(k0 + kk) * N] : 0.f; }
#pragma unroll
    for (int i = 0; i < 32; ++i) { const int kk = 2 * i + (lane >> 5); scr[kk * 33 + (lane & 31)] = gk ? v[i] * gk[k0 + kk] : v[i]; }
    LDS_WAIT(); asm volatile("" ::: "memory");
    const int c = lane & 7;
#pragma unroll
    for (int j = 0; j < 4; ++j) { const int n = (lane >> 3) + 8 * j; const LAS float* s = scr + (8 * c) * 33 + n;
        u32x4 o; o.x = cvt_pk_bf16(s[0 * 33], s[1 * 33]); o.y = cvt_pk_bf16(s[2 * 33], s[3 * 33]); o.z = cvt_pk_bf16(s[4 * 33], s[5 * 33]); o.w = cvt_pk_bf16(s[6 * 33], s[7 * 33]);
        *(u32x4*)(WT + (size_t)(n0 + n) * ldw + koff + k0 + 8 * c) = o; }
    LDS_WAIT(); asm volatile("" ::: "memory");
}

__device__ __forceinline__ void transpose_item4(const float* colp, int N, const float* gk, bf16_t* WT, int ldw, int koff, int k0, int n0, LAS float* scr, int lane) {
    const int kk = lane >> 4, nq = lane & 15;
    f32x4 v[16];
#pragma unroll
    for (int i = 0; i < 16; ++i) v[i] = colp ? *(const f32x4*)(colp + (size_t)(k0 + 4 * i + kk) * N) : (f32x4){0.f, 0.f, 0.f, 0.f};
#pragma unroll
    for (int i = 0; i < 16; ++i) { const int k = 4 * i + kk; const float g = gk ? gk[k0 + k] : 1.f; LAS float* d = scr + k * 65 + 4 * nq;
        d[0] = v[i][0] * g; d[1] = v[i][1] * g; d[2] = v[i][2] * g; d[3] = v[i][3] * g; }
    LDS_WAIT(); asm volatile("" ::: "memory");
    const int c = lane & 7;
#pragma unroll
    for (int j = 0; j < 8; ++j) { const int n = (lane >> 3) + 8 * j; const LAS float* sp = scr + (8 * c) * 65 + n;
        u32x4 o; o.x = cvt_pk_bf16(sp[0 * 65], sp[1 * 65]); o.y = cvt_pk_bf16(sp[2 * 65], sp[3 * 65]); o.z = cvt_pk_bf16(sp[4 * 65], sp[5 * 65]); o.w = cvt_pk_bf16(sp[6 * 65], sp[7 * 65]);
        *(u32x4*)(WT + (size_t)(n0 + n) * ldw + koff + k0 + 8 * c) = o; }
    LDS_WAIT(); asm volatile("" ::: "memory");
}

struct Args {
    const float* x; const int* pos;
    const float *g1, *w1g, *w1u, *w1d, *gmix, *win, *bi, *bf, *gno, *sinks, *wbm, *wba, *wo, *g2, *w2g, *w2u, *w2d, *gfin;
    float* out; unsigned char* ws; int ph_lo, ph_hi;
};

__device__ __forceinline__ void p0_prologue(const Args& a, LAS unsigned char* lds, int gw, int NGW, int wave, int lane) {
    unsigned char* ws = a.ws;
    LAS float* scr = (LAS float*)(lds + wave * 16896);
    constexpr int I_GU = (DM / 64) * (NGU / 64), I_D = (DFF / 64) * (DM / 64), I_IN = (DM / 64) * (NIN / 64), I_BR = (512 / 64) * (DM / 64), I_O = (DM / 64) * (DM / 64);
    constexpr int NITEMS = 2 * I_GU + 2 * I_D + I_IN + 2 * I_BR + I_O;
    for (int it = gw; it < NITEMS; it += NGW) {
        int r = it;
        if (r < 2 * I_GU) {
            const bool second = r >= I_GU; if (second) r -= I_GU;
            const int nblk = NGU / 64, kb = r / nblk, nb = r % nblk, n = nb * 64 + 4 * (lane & 15);
            const float* wg = second ? a.w2g : a.w1g; const float* wu = second ? a.w2u : a.w1u;
            const float* colp = (((n >> 7) & 1) ? wu : wg) + 128 * (n >> 8) + (n & 127);
            transpose_item4(colp, DFF, second ? a.g2 : a.g1, (bf16_t*)(ws + (second ? WS_W2GU : WS_W1GU)), DM, 0, kb * 64, nb * 64, scr, lane);
            continue;
        }
        r -= 2 * I_GU;
        if (r < 2 * I_D) {
            const bool second = r >= I_D; if (second) r -= I_D;
            const int nblk = DM / 64, kb = r / nblk, nb = r % nblk, n = nb * 64 + 4 * (lane & 15);
            transpose_item4((second ? a.w2d : a.w1d) + n, DM, nullptr, (bf16_t*)(ws + (second ? WS_W2D : WS_W1D)), DFF, 0, kb * 64, nb * 64, scr, lane);
            continue;
        }
        r -= 2 * I_D;
        if (r < I_IN) {
            const int nblk = NIN / 64, kb = r / nblk, nb = r % nblk, n = nb * 64 + 4 * (lane & 15);
            int src = -1;
            if (n < 1536) src = n; else if (n < 2304) src = n + 8;
            else if (n < 4352) { const int t = n - 2304; src = (((t >> 7) & 1) ? 3336 : 2312) + 128 * (t >> 8) + (t & 127); }
            else if (n < 4360) src = n - 4352 + 1536;
            transpose_item4(src >= 0 ? a.win + src : nullptr, WIN_SRC, a.gmix, (bf16_t*)(ws + WS_WIN), DM, 0, kb * 64, nb * 64, scr, lane);
            continue;
        }
        r -= I_IN;
        if (r < 2 * I_BR) {
            const bool second = r >= I_BR; if (second) r -= I_BR;
            const int nblk = DM / 64, kb = r / nblk, nb = r % nblk, n = nb * 64 + 4 * (lane & 15);
            transpose_item4((second ? a.wba : a.wbm) + n, DM, nullptr, (bf16_t*)(ws + WS_WBR), DM, second ? 512 : 0, kb * 64, nb * 64, scr, lane);
            continue;
        }
        r -= 2 * I_BR;
        { const int nblk = DM / 64, kb = r / nblk, nb = r % nblk, n = nb * 64 + 4 * (lane & 15);
          transpose_item4(a.wo + n, DM, nullptr, (bf16_t*)(ws + WS_WO), DM, 0, kb * 64, nb * 64, scr, lane); }
    }
    float* ss0 = (float*)(ws + WS_SS);
    bf16_t* XB = (bf16_t*)(ws + WS_XB);
    for (int m0 = gw; m0 < M; m0 += 8 * NGW) {
        f32x4 v[8][4];
#pragma unroll
        for (int r = 0; r < 8; ++r) { const int m = m0 + r * NGW; const f32x4* xr = (const f32x4*)(a.x + (size_t)(m < M ? m : gw) * DM) + lane;
#pragma unroll
            for (int j = 0; j < 4; ++j) v[r][j] = xr[64 * j]; }
#pragma unroll
        for (int r = 0; r < 8; ++r) { const int m = m0 + r * NGW; if (m >= M) break;
            float s = 0.f;
#pragma unroll
            for (int j = 0; j < 4; ++j) s += (v[r][j].x * v[r][j].x + v[r][j].y * v[r][j].y) + (v[r][j].z * v[r][j].z + v[r][j].w * v[r][j].w);
            s = wave_sum(s);
            if (lane == 0) ss0[m] = s;
            u32x2* o8 = (u32x2*)(XB + (size_t)m * DM) + lane;
#pragma unroll
            for (int j = 0; j < 4; ++j) { u32x2 w; w.x = cvt_pk_bf16(v[r][j].x, v[r][j].y); w.y = cvt_pk_bf16(v[r][j].z, v[r][j].w); o8[64 * j] = w; } }
    }
    float* rope = (float*)(ws + WS_ROPE);
    for (int idx = gw * 64 + lane; idx < M * 8; idx += NGW * 64) {
        const int row = idx >> 3, i = idx & 7;
        const float inv = i == 0 ? 1.0f : i == 1 ? 0.1939227432012558f : i == 2 ? 0.03760603070259094f : i == 3 ? 0.007292664609849453f : i == 4 ? 0.0014142135623842478f
                        : i == 5 ? 0.00027424818836152554f : i == 6 ? 5.3182957344688475e-05f : 1.0313385246263351e-05f;
        const float ang = (float)a.pos[row] * inv; float sn, cs; sincosf(ang, &sn, &cs);
        rope[(size_t)row * 16 + i] = cs; rope[(size_t)row * 16 + 8 + i] = sn;
    }
}

#define MFMA16(a, b, c) __builtin_amdgcn_mfma_f32_16x16x32_bf16((a), (b), (c), 0, 0, 0)
constexpr int ML_QS = 0, ML_KS = 9216, ML_KWT = 18432, ML_VT = 27648, ML_SQK = 46080, ML_CB = 55296, ML_HB = 73728, ML_SC = 107520;
constexpr int ML_TB = 109056;
constexpr int LP = 72;
constexpr int HBP = 132;

constexpr int ML_GROUP = 8, ML_NG = (SEQ / 64) / ML_GROUP;
__device__ __forceinline__ float fast_tanh(float x) { return 1.f - 2.f * __builtin_amdgcn_rcpf(1.f + __expf(2.f * x)); }

template <bool STATE_ONLY>
__device__ __forceinline__ void mlstm_group(const Args& a, LAS unsigned char* lds, int bh, int grp, int tid, int wave, int lane) {
    const int b = bh >> 2, h = bh & 3;
    const bf16_t* P = (const bf16_t*)(a.ws + WS_ACT);
    const float* GT = (const float*)(a.ws + WS_GATES);
    bf16_t* HO = (bf16_t*)(a.ws + WS_HO);
    float* CG = (float*)(a.ws + WS_CG); float* NGs = (float*)(a.ws + WS_NG); float* SG = (float*)(a.ws + WS_SG); float* CHS = (float*)(a.ws + WS_CHS);
    LAS bf16_t* QS = (LAS bf16_t*)(lds + ML_QS); LAS bf16_t* KS = (LAS bf16_t*)(lds + ML_KS); LAS bf16_t* KWT = (LAS bf16_t*)(lds + ML_KWT);
    LAS bf16_t* VT = (LAS bf16_t*)(lds + ML_VT); LAS bf16_t* SQK = (LAS bf16_t*)(lds + ML_SQK); LAS bf16_t* CB = (LAS bf16_t*)(lds + ML_CB);
    LAS float* HB = (LAS float*)(lds + ML_HB); LAS float* SC = (LAS float*)(lds + ML_SC);
    LAS float* s_rowterm = SC, * s_dcol = SC + 64, * s_iscale = SC + 128, * s_emrow = SC + 192, * s_n = SC + 256;
    const int fr = lane & 15, fq = lane >> 4;
    const float b_i = a.bi[h], b_f = a.bf[h];
    const int c0 = grp * ML_GROUP;
    f32x4 cacc[4];
#pragma unroll
    for (int kt = 0; kt < 4; ++kt) cacc[kt] = (f32x4){0.f, 0.f, 0.f, 0.f};
    float m_prev, bsum = 0.f;
    if constexpr (STATE_ONLY) {
        m_prev = -1e30f;
        if (tid < 64) s_n[(c0 & 1) * 64 + tid] = 0.f;
    } else {
        float m = 0.f;
        for (int c = 0; c < c0; ++c) { const float bl_c = CHS[(bh * 32 + c) * 2], am_c = CHS[(bh * 32 + c) * 2 + 1]; m = fmaxf(bl_c + m, am_c); }
        m_prev = m;
        float nacc = 0.f;
        for (int gp = 0; gp < grp; ++gp) {
            float e = SG[(bh * 4 + gp) * 2] - m;
            for (int g2 = gp + 1; g2 < grp; ++g2) e += SG[(bh * 4 + g2) * 2 + 1];
            const float coef = __expf(e);
            const float* cg = CG + (size_t)(bh * 4 + gp) * 8192;
#pragma unroll
            for (int kt = 0; kt < 4; ++kt)
#pragma unroll
                for (int i = 0; i < 4; ++i) cacc[kt][i] += coef * cg[(16 * wave + 4 * fq + i) * 64 + 16 * kt + fr];
            if (tid < 64) nacc += coef * NGs[(bh * 4 + gp) * 64 + tid];
        }
        if (tid < 64) s_n[(c0 & 1) * 64 + tid] = nacc;
#pragma unroll
        for (int kt = 0; kt < 4; ++kt)
#pragma unroll
            for (int i = 0; i < 4; ++i) CB[(16 * wave + 4 * fq + i) * LP + 16 * kt + fr] = f2bf(cacc[kt][i]);
    }
    const int l_qk = tid >> 3, pc_qk = tid & 7;
    const int j_n = tid >> 3, seg_n = tid & 7;
    const size_t rowbase = (size_t)b * SEQ;
    const int lp = tid & 31, pcg = tid >> 5;
    constexpr int PD = STATE_ONLY ? ML_GROUP : 2;
    u32x4 rq[PD], rk[PD], rv[PD][2], ro[PD][2]; u32x2 rk2[PD][2];
#define ML_LOAD(c, S) do { const size_t r0_ = rowbase + (size_t)(c) * 64; \
        if constexpr (!STATE_ONLY) { rk[S] = *(const u32x4*)(P + (r0_ + l_qk) * NIN + PC_KM + h * 64 + pc_qk * 8); rq[S] = *(const u32x4*)(P + (r0_ + l_qk) * NIN + PC_QM + h * 64 + pc_qk * 8); } \
        _Pragma("unroll") for (int i_ = 0; i_ < 2; ++i_) { rv[S][i_] = *(const u32x4*)(P + (r0_ + 2 * lp + i_) * NIN + PC_VM + h * 128 + pcg * 8); \
            rk2[S][i_] = *(const u32x2*)(P + (r0_ + 2 * lp + i_) * NIN + PC_KM + h * 64 + pcg * 4); \
            if constexpr (!STATE_ONLY) ro[S][i_] = *(const u32x4*)(P + (r0_ + j_n) * NIN + PC_OM + h * 128 + seg_n * 16 + i_ * 8); } } while (0)
#pragma unroll
    for (int d = 0; d < PD; ++d) ML_LOAD(c0 + d, d);
    LAS float* T_av = (LAS float*)(lds + ML_TB); LAS float* T_dcol = T_av + 512; LAS float* T_pmx = T_dcol + 512; LAS float* T_bc = T_pmx + 512; LAS float* T_sc = T_bc + 512;
    {
        const size_t r = rowbase + (size_t)(c0 + wave) * 64 + lane;
        const float gi = GT[r * 8 + h], gf = GT[r * 8 + 4 + h];
        const float ipre = 15.f * fast_tanh((gi + b_i) * (1.f / 15.f)), fpre = 15.f * fast_tanh((gf + b_f) * (1.f / 15.f));
        float bc = -__logf(1.f + __expf(-fpre));
#pragma unroll
        for (int o = 1; o < 64; o <<= 1) { const float t = __shfl_up(bc, o); if (lane >= o) bc += t; }
        const float bl = __shfl(bc, 63);
        const float av = bl - bc + ipre;
        float amax = av;
#pragma unroll
        for (int o = 1; o < 64; o <<= 1) amax = fmaxf(amax, __shfl_xor(amax, o));
        const float dcol = ipre - bc;
        float pmx = dcol;
#pragma unroll
        for (int o = 1; o < 64; o <<= 1) { const float t = __shfl_up(pmx, o); if (lane >= o) pmx = fmaxf(pmx, t); }
        T_av[wave * 64 + lane] = av; T_dcol[wave * 64 + lane] = dcol; T_pmx[wave * 64 + lane] = pmx; T_bc[wave * 64 + lane] = bc;
        if (lane == 0) { T_sc[wave] = bl; T_sc[8 + wave] = amax;
            if constexpr (STATE_ONLY) { CHS[(bh * 32 + c0 + wave) * 2] = bl; CHS[(bh * 32 + c0 + wave) * 2 + 1] = amax; } }
    }
    __syncthreads();
#pragma unroll PD
    for (int ci = 0; ci < ML_GROUP; ++ci) {
        const int c = c0 + ci, si = ci % PD;
        LAS float* n_cur = s_n + (c & 1) * 64; LAS float* n_nxt = s_n + ((c + 1) & 1) * 64;
        const float bl = T_sc[ci], amax = T_sc[8 + ci];
        const float m_new = fmaxf(bl + m_prev, amax);
        const float decay = __expf(bl + m_prev - m_new);
        if constexpr (STATE_ONLY) bsum += bl;
        if constexpr (!STATE_ONLY) {
            if (wave == 0) { const float pmx = T_pmx[ci * 64 + lane], bc = T_bc[ci * 64 + lane], mx = fmaxf(m_prev, pmx);
                s_rowterm[lane] = -mx; s_dcol[lane] = T_dcol[ci * 64 + lane]; s_iscale[lane] = __expf(m_prev - mx); s_emrow[lane] = __expf(-(bc + mx)); }
        }
        {
            if constexpr (!STATE_ONLY) {
                u32x4 q2;
                const u32x4 rqs = rq[si];
                q2.x = cvt_pk_bf16(bflo(rqs.x) * 0.125f, bfhi(rqs.x) * 0.125f); q2.y = cvt_pk_bf16(bflo(rqs.y) * 0.125f, bfhi(rqs.y) * 0.125f);
                q2.z = cvt_pk_bf16(bflo(rqs.z) * 0.125f, bfhi(rqs.z) * 0.125f); q2.w = cvt_pk_bf16(bflo(rqs.w) * 0.125f, bfhi(rqs.w) * 0.125f);
                *(LAS u32x4*)(QS + l_qk * LP + pc_qk * 8) = q2;
                *(LAS u32x4*)(KS + l_qk * LP + pc_qk * 8) = rk[si];
            }
            const f32x2 av2 = *(const LAS f32x2*)(T_av + ci * 64 + 2 * lp);
            const float wA = __expf(av2.x - m_new), wB = __expf(av2.y - m_new);
            LAS unsigned* KWT32 = (LAS unsigned*)KWT; LAS unsigned* VT32 = (LAS unsigned*)VT;
#pragma unroll
            for (int q = 0; q < 2; ++q) { const unsigned ka = rk2[si][0][q], kb = rk2[si][1][q];
                KWT32[(pcg * 4 + 2 * q) * (LP / 2) + lp] = cvt_pk_bf16(bflo(ka) * wA, bflo(kb) * wB); KWT32[(pcg * 4 + 2 * q + 1) * (LP / 2) + lp] = cvt_pk_bf16(bfhi(ka) * wA, bfhi(kb) * wB); }
#pragma unroll
            for (int q = 0; q < 4; ++q) { const unsigned va = rv[si][0][q], vb = rv[si][1][q];
                VT32[(pcg * 8 + 2 * q) * (LP / 2) + lp] = (va & 0xffffu) | (vb << 16); VT32[(pcg * 8 + 2 * q + 1) * (LP / 2) + lp] = (va >> 16) | (vb & 0xffff0000u); }
        }
        u32x4 og0, og1;
        if constexpr (!STATE_ONLY) { og0 = ro[si][0]; og1 = ro[si][1]; }
        if (ci + PD < ML_GROUP) ML_LOAD(c + PD, si);
        __syncthreads();
        {
            if constexpr (!STATE_ONLY) {
                const int jt = wave >> 1, j = 16 * jt + fr;
                const bf16x8 bq0 = *(const LAS bf16x8*)(QS + j * LP + 8 * fq), bq1 = *(const LAS bf16x8*)(QS + j * LP + 32 + 8 * fq);
                const float rtm = s_rowterm[j], isc = s_iscale[j], emr = s_emrow[j];
                f32x4 sq[4]; float dsum = 0.f;
#pragma unroll
                for (int ct = 0; ct < 4; ++ct) {
                    const bf16x8 k0 = *(const LAS bf16x8*)(KS + (16 * ct + fr) * LP + 8 * fq), k1 = *(const LAS bf16x8*)(KS + (16 * ct + fr) * LP + 32 + 8 * fq);
                    f32x4 v = (f32x4){0.f, 0.f, 0.f, 0.f};
                    v = MFMA16(k0, bq0, v); v = MFMA16(k1, bq1, v);
                    const f32x4 dc = *(const LAS f32x4*)(s_dcol + 16 * ct + 4 * fq);
#pragma unroll
                    for (int i = 0; i < 4; ++i) { const float p = (16 * ct + 4 * fq + i <= j) ? v[i] * __expf(rtm + dc[i]) : 0.f; v[i] = p; dsum += p; }
                    sq[ct] = v;
                }
                float qn = 0.f;
                {
                    const f32x4 n0 = *(const LAS f32x4*)(n_cur + 8 * fq), n1 = *(const LAS f32x4*)(n_cur + 8 * fq + 4), n2 = *(const LAS f32x4*)(n_cur + 32 + 8 * fq), n3 = *(const LAS f32x4*)(n_cur + 32 + 8 * fq + 4);
                    const u32x4 q0 = __builtin_bit_cast(u32x4, bq0), q1 = __builtin_bit_cast(u32x4, bq1);
                    qn += bflo(q0[0]) * n0[0] + bfhi(q0[0]) * n0[1] + bflo(q0[1]) * n0[2] + bfhi(q0[1]) * n0[3];
                    qn += bflo(q0[2]) * n1[0] + bfhi(q0[2]) * n1[1] + bflo(q0[3]) * n1[2] + bfhi(q0[3]) * n1[3];
                    qn += bflo(q1[0]) * n2[0] + bfhi(q1[0]) * n2[1] + bflo(q1[1]) * n2[2] + bfhi(q1[1]) * n2[3];
                    qn += bflo(q1[2]) * n3[0] + bfhi(q1[2]) * n3[1] + bflo(q1[3]) * n3[2] + bfhi(q1[3]) * n3[3];
                }
                float den = dsum + isc * qn;
                den += __shfl_xor(den, 16); den += __shfl_xor(den, 32);
                const float dnm = __builtin_amdgcn_rcpf(fmaxf(fabsf(den), emr));
                bf16x8 pf[2];
#pragma unroll
                for (int ks = 0; ks < 2; ++ks) { u32x4 w; w.x = cvt_pk_bf16(sq[2 * ks][0], sq[2 * ks][1]); w.y = cvt_pk_bf16(sq[2 * ks][2], sq[2 * ks][3]);
                    w.z = cvt_pk_bf16(sq[2 * ks + 1][0], sq[2 * ks + 1][1]); w.w = cvt_pk_bf16(sq[2 * ks + 1][2], sq[2 * ks + 1][3]); pf[ks] = __builtin_bit_cast(bf16x8, w); }
#pragma unroll
                for (int tt = 0; tt < 4; ++tt) {
                    const int et = 4 * (wave & 1) + tt;
                    const LAS bf16_t* vp = VT + (16 * et + fr) * LP + 4 * fq;
                    f32x4 xa = (f32x4){0.f, 0.f, 0.f, 0.f}, xb = (f32x4){0.f, 0.f, 0.f, 0.f};
#pragma unroll
                    for (int ks = 0; ks < 2; ++ks) { const u32x2 lo = *(const LAS u32x2*)(vp + 32 * ks), hi2 = *(const LAS u32x2*)(vp + 32 * ks + 16);
                        xa = MFMA16(__builtin_bit_cast(bf16x8, ((u32x4){lo.x, lo.y, hi2.x, hi2.y})), pf[ks], xa); }
                    const bf16x8 cb0 = *(const LAS bf16x8*)(CB + (16 * et + fr) * LP + 8 * fq), cb1 = *(const LAS bf16x8*)(CB + (16 * et + fr) * LP + 32 + 8 * fq);
                    xb = MFMA16(cb0, bq0, xb); xb = MFMA16(cb1, bq1, xb);
                    *(LAS f32x4*)(HB + j * HBP + 16 * et + 4 * fq) = (xa + xb * isc) * dnm;
                }
            }
            const bf16x8 va0 = *(const LAS bf16x8*)(VT + (16 * wave + fr) * LP + 8 * fq), va1 = *(const LAS bf16x8*)(VT + (16 * wave + fr) * LP + 32 + 8 * fq);
#pragma unroll
            for (int kt = 0; kt < 4; ++kt) {
                const bf16x8 kb0 = *(const LAS bf16x8*)(KWT + (16 * kt + fr) * LP + 8 * fq), kb1 = *(const LAS bf16x8*)(KWT + (16 * kt + fr) * LP + 32 + 8 * fq);
                f32x4 t = cacc[kt] * decay;
                t = MFMA16(va0, kb0, t); t = MFMA16(va1, kb1, t);
                cacc[kt] = t;
            }
            {
                const u32x4 kv = *(const LAS u32x4*)(KWT + j_n * LP + seg_n * 8);
                float sn = (bflo(kv[0]) + bfhi(kv[0])) + (bflo(kv[1]) + bfhi(kv[1])) + (bflo(kv[2]) + bfhi(kv[2])) + (bflo(kv[3]) + bfhi(kv[3]));
                sn += __shfl_xor(sn, 1); sn += __shfl_xor(sn, 2); sn += __shfl_xor(sn, 4);
                if (seg_n == 0) n_nxt[j_n] = decay * n_cur[j_n] + sn;
            }
        }
        __syncthreads();
        if constexpr (!STATE_ONLY) {
#pragma unroll
            for (int kt = 0; kt < 4; ++kt)
#pragma unroll
                for (int i = 0; i < 4; ++i) CB[(16 * wave + 4 * fq + i) * LP + 16 * kt + fr] = f2bf(cacc[kt][i]);
            float hv[16]; float sq = 0.f;
#pragma unroll
            for (int q = 0; q < 4; ++q) { const f32x4 t = *(const LAS f32x4*)(HB + j_n * HBP + seg_n * 16 + 4 * q); hv[4 * q] = t[0]; hv[4 * q + 1] = t[1]; hv[4 * q + 2] = t[2]; hv[4 * q + 3] = t[3];
                sq += (t[0] * t[0] + t[1] * t[1]) + (t[2] * t[2] + t[3] * t[3]); }
            sq += __shfl_xor(sq, 1); sq += __shfl_xor(sq, 2); sq += __shfl_xor(sq, 4);
            const float rn = rsqrtf(sq * (1.0f / 128.f) + NORM_EPS);
            const float* gp = a.gno + h * 128 + seg_n * 16;
            float ov[16];
#pragma unroll
            for (int q = 0; q < 4; ++q) { ov[2 * q] = bflo(og0[q]); ov[2 * q + 1] = bfhi(og0[q]); ov[8 + 2 * q] = bflo(og1[q]); ov[8 + 2 * q + 1] = bfhi(og1[q]); }
            unsigned pk[8];
#pragma unroll
            for (int q = 0; q < 8; ++q) { const float v0 = hv[2 * q] * rn * gp[2 * q] * sigm(ov[2 * q]), v1 = hv[2 * q + 1] * rn * gp[2 * q + 1] * sigm(ov[2 * q + 1]); pk[q] = cvt_pk_bf16(v0, v1); }
            bf16_t* dst = HO + (rowbase + (size_t)c * 64 + j_n) * DM + h * 128 + seg_n * 16;
            *(u32x4*)dst = (u32x4){pk[0], pk[1], pk[2], pk[3]}; *(u32x4*)(dst + 8) = (u32x4){pk[4], pk[5], pk[6], pk[7]};
        }
        m_prev = m_new;
    }
    if constexpr (STATE_ONLY) {
        float* cg = CG + (size_t)(bh * 4 + grp) * 8192;
#pragma unroll
        for (int kt = 0; kt < 4; ++kt)
#pragma unroll
            for (int i = 0; i < 4; ++i) cg[(16 * wave + 4 * fq + i) * 64 + 16 * kt + fr] = cacc[kt][i];
        if (tid < 64) NGs[(bh * 4 + grp) * 64 + tid] = s_n[((c0 + ML_GROUP) & 1) * 64 + tid];
        if (tid == 0) { SG[(bh * 4 + grp) * 2] = m_prev; SG[(bh * 4 + grp) * 2 + 1] = bsum; }
    }
    __syncthreads();
#undef ML_LOAD
}

constexpr int ML2_VT = 0, ML2_KWT = 67584, LP2 = 264;
__device__ __forceinline__ void mlstm_state_group(const Args& a, LAS unsigned char* lds, int bh, int grp, int tid, int wave, int lane) {
    const int b = bh >> 2, h = bh & 3;
    const bf16_t* P = (const bf16_t*)(a.ws + WS_ACT);
    const float* GT = (const float*)(a.ws + WS_GATES);
    float* CG = (float*)(a.ws + WS_CG); float* NGs = (float*)(a.ws + WS_NG); float* SG = (float*)(a.ws + WS_SG); float* CHS = (float*)(a.ws + WS_CHS);
    LAS bf16_t* VT = (LAS bf16_t*)(lds + ML2_VT); LAS bf16_t* KWT = (LAS bf16_t*)(lds + ML2_KWT);
    LAS float* T_av = (LAS float*)(lds + ML_TB); LAS float* T_sc = T_av + 2048;
    const int fr = lane & 15, fq = lane >> 4;
    const float b_i = a.bi[h], b_f = a.bf[h];
    const int c0 = grp * ML_GROUP;
    const size_t rowbase = (size_t)b * SEQ;
    const int lp = tid & 31, pcg = tid >> 5;
    u32x4 rv[ML_GROUP][2]; u32x2 rk2[ML_GROUP][2];
#pragma unroll
    for (int ci = 0; ci < ML_GROUP; ++ci) { const size_t r0 = rowbase + (size_t)(c0 + ci) * 64;
#pragma unroll
        for (int i = 0; i < 2; ++i) { rv[ci][i] = *(const u32x4*)(P + (r0 + 2 * lp + i) * NIN + PC_VM + h * 128 + pcg * 8); rk2[ci][i] = *(const u32x2*)(P + (r0 + 2 * lp + i) * NIN + PC_KM + h * 64 + pcg * 4); } }
    {
        const size_t r = rowbase + (size_t)(c0 + wave) * 64 + lane;
        const float gi = GT[r * 8 + h], gf = GT[r * 8 + 4 + h];
        const float ipre = 15.f * fast_tanh((gi + b_i) * (1.f / 15.f)), fpre = 15.f * fast_tanh((gf + b_f) * (1.f / 15.f));
        float bc = -__logf(1.f + __expf(-fpre));
#pragma unroll
        for (int o = 1; o < 64; o <<= 1) { const float t = __shfl_up(bc, o); if (lane >= o) bc += t; }
        const float bl = __shfl(bc, 63);
        const float av = bl - bc + ipre;
        float amax = av;
#pragma unroll
        for (int o = 1; o < 64; o <<= 1) amax = fmaxf(amax, __shfl_xor(amax, o));
        T_av[wave * 64 + lane] = av;
        if (lane == 0) { T_sc[wave] = bl; T_sc[8 + wave] = amax; CHS[(bh * 32 + c0 + wave) * 2] = bl; CHS[(bh * 32 + c0 + wave) * 2 + 1] = amax; }
    }
    __syncthreads();
    float m_g = -1e30f, bsum = 0.f, sufB[ML_GROUP];
#pragma unroll
    for (int ci = 0; ci < ML_GROUP; ++ci) { m_g = fmaxf(T_sc[ci] + m_g, T_sc[8 + ci]); bsum += T_sc[ci]; }
    { float acc = 0.f;
#pragma unroll
      for (int ci = ML_GROUP - 1; ci >= 0; --ci) { sufB[ci] = acc; acc += T_sc[ci]; } }
    f32x4 cacc[4];
#pragma unroll
    for (int kt = 0; kt < 4; ++kt) cacc[kt] = (f32x4){0.f, 0.f, 0.f, 0.f};
    float nacc = 0.f;
    LAS unsigned* KWT32 = (LAS unsigned*)KWT; LAS unsigned* VT32 = (LAS unsigned*)VT;
#pragma unroll
    for (int hf = 0; hf < 2; ++hf) {
#pragma unroll
        for (int cc = 0; cc < 4; ++cc) {
            const int ci = 4 * hf + cc;
            const f32x2 av2 = *(const LAS f32x2*)(T_av + ci * 64 + 2 * lp);
            const float wA = __expf(av2.x + sufB[ci] - m_g), wB = __expf(av2.y + sufB[ci] - m_g);
#pragma unroll
            for (int q = 0; q < 2; ++q) { const unsigned ka = rk2[ci][0][q], kb = rk2[ci][1][q];
                KWT32[(pcg * 4 + 2 * q) * (LP2 / 2) + 32 * cc + lp] = cvt_pk_bf16(bflo(ka) * wA, bflo(kb) * wB); KWT32[(pcg * 4 + 2 * q + 1) * (LP2 / 2) + 32 * cc + lp] = cvt_pk_bf16(bfhi(ka) * wA, bfhi(kb) * wB); }
#pragma unroll
            for (int q = 0; q < 4; ++q) { const unsigned va = rv[ci][0][q], vb = rv[ci][1][q];
                VT32[(pcg * 8 + 2 * q) * (LP2 / 2) + 32 * cc + lp] = (va & 0xffffu) | (vb << 16); VT32[(pcg * 8 + 2 * q + 1) * (LP2 / 2) + 32 * cc + lp] = (va >> 16) | (vb & 0xffff0000u); }
        }
        __syncthreads();
#pragma unroll
        for (int ks = 0; ks < 8; ++ks) {
            const bf16x8 va = *(const LAS bf16x8*)(VT + (16 * wave + fr) * LP2 + 32 * ks + 8 * fq);
#pragma unroll
            for (int kt = 0; kt < 4; ++kt) { const bf16x8 kb = *(const LAS bf16x8*)(KWT + (16 * kt + fr) * LP2 + 32 * ks + 8 * fq); cacc[kt] = MFMA16(va, kb, cacc[kt]); }
        }
        {
            const int k = tid >> 3, seg = tid & 7; float sn = 0.f;
#pragma unroll
            for (int q4 = 0; q4 < 4; ++q4) { const u32x4 kv = *(const LAS u32x4*)(KWT + k * LP2 + seg * 32 + q4 * 8);
                sn += (bflo(kv[0]) + bfhi(kv[0])) + (bflo(kv[1]) + bfhi(kv[1])) + (bflo(kv[2]) + bfhi(kv[2])) + (bflo(kv[3]) + bfhi(kv[3])); }
            sn += __shfl_xor(sn, 1); sn += __shfl_xor(sn, 2); sn += __shfl_xor(sn, 4);
            nacc += sn;
        }
        __syncthreads();
    }
    float* cg = CG + (size_t)(bh * 4 + grp) * 8192;
#pragma unroll
    for (int kt = 0; kt < 4; ++kt)
#pragma unroll
        for (int i = 0; i < 4; ++i) cg[(16 * wave + 4 * fq + i) * 64 + 16 * kt + fr] = cacc[kt][i];
    if ((tid & 7) == 0) NGs[(bh * 4 + grp) * 64 + (tid >> 3)] = nacc;
    if (tid == 0) { SG[(bh * 4 + grp) * 2] = m_g; SG[(bh * 4 + grp) * 2 + 1] = bsum; }
}

constexpr int AT_KS = 0, AT_VT = 27648, AT_QS = 53248, AT_PS = 90112;
constexpr int VP = 200;

__device__ __forceinline__ void rope16(float (&x)[16], const float* tab) {
    const f32x4 c0 = *(const f32x4*)tab, c1 = *(const f32x4*)(tab + 4), s0 = *(const f32x4*)(tab + 8), s1 = *(const f32x4*)(tab + 12);
#pragma unroll
    for (int i = 0; i < 8; ++i) { const float cs = i < 4 ? c0[i & 3] : c1[i & 3], sn = i < 4 ? s0[i & 3] : s1[i & 3]; const float x1 = x[i], x2 = x[i + 8]; x[i] = x1 * cs - x2 * sn; x[i + 8] = x2 * cs + x1 * sn; }
}

__device__ __forceinline__ void attn_item(const Args& a, LAS unsigned char* lds, int item, int tid, int wave, int lane) {
    const int qb = item & 31, kvh = (item >> 5) & 1, b = item >> 6;
    const int q0 = qb * 64;
    const bf16_t* P = (const bf16_t*)(a.ws + WS_ACT);
    const float* rope = (const float*)(a.ws + WS_ROPE);
    bf16_t* HO = (bf16_t*)(a.ws + WS_HO);
    LAS bf16_t* KS = (LAS bf16_t*)(lds + AT_KS); LAS bf16_t* VT = (LAS bf16_t*)(lds + AT_VT); LAS bf16_t* QS = (LAS bf16_t*)(lds + AT_QS);
    LAS bf16_t* PS = (LAS bf16_t*)(lds + AT_PS) + wave * 16 * VP;
    const int fr = lane & 15, fq = lane >> 4;
    const size_t rowbase = (size_t)b * SEQ;
    const int grp = tid & 3;
    u32x4 kk[2][2], vv[2][2], qq[2][2]; f32x4 tk[2][4], tq[2][4];
#pragma unroll
    for (int it = 0; it < 2; ++it) {
        const int t = tid + 512 * it;
        const int kc = (t >> 2) < 192 ? (t >> 2) : 191, kpos = q0 - 128 + kc, kposc = kpos < 0 ? 0 : kpos;
        const bf16_t* kp = P + (rowbase + kposc) * NIN + PC_KA + kvh * 64 + grp * 16; kk[it][0] = *(const u32x4*)kp; kk[it][1] = *(const u32x4*)(kp + 8);
        const bf16_t* vp = P + (rowbase + kposc) * NIN + PC_VA + kvh * 64 + grp * 16; vv[it][0] = *(const u32x4*)vp; vv[it][1] = *(const u32x4*)(vp + 8);
        const float* tkp = rope + (rowbase + kposc) * 16;
#pragma unroll
        for (int q = 0; q < 4; ++q) tk[it][q] = *(const f32x4*)(tkp + 4 * q);
        const int qi = (t >> 2) & 63, gq = t >> 8;
        const size_t row = rowbase + q0 + qi;
        const bf16_t* qp = P + row * NIN + PC_QA + (kvh * 4 + gq) * 64 + grp * 16; qq[it][0] = *(const u32x4*)qp; qq[it][1] = *(const u32x4*)(qp + 8);
        const float* tqp = rope + row * 16;
#pragma unroll
        for (int q = 0; q < 4; ++q) tq[it][q] = *(const f32x4*)(tqp + 4 * q);
    }
#pragma unroll
    for (int it = 0; it < 2; ++it) {
        const int t = tid + 512 * it;
        {
            const int kc = t >> 2, kpos = q0 - 128 + kc;
            const bool live = (t < 768), ok = kpos >= 0;
            u32x4 k0 = kk[it][0], k1 = kk[it][1], v0 = vv[it][0], v1 = vv[it][1];
            if (grp == 0) {
                float x[16];
#pragma unroll
                for (int q = 0; q < 4; ++q) { x[2 * q] = bflo(k0[q]); x[2 * q + 1] = bfhi(k0[q]); x[8 + 2 * q] = bflo(k1[q]); x[8 + 2 * q + 1] = bfhi(k1[q]); }
#pragma unroll
                for (int i = 0; i < 8; ++i) { const float cs = tk[it][i >> 2][i & 3], sn = tk[it][2 + (i >> 2)][i & 3]; const float x1 = x[i], x2 = x[i + 8]; x[i] = x1 * cs - x2 * sn; x[i + 8] = x2 * cs + x1 * sn; }
#pragma unroll
                for (int q = 0; q < 4; ++q) { k0[q] = cvt_pk_bf16(x[2 * q], x[2 * q + 1]); k1[q] = cvt_pk_bf16(x[8 + 2 * q], x[8 + 2 * q + 1]); }
            }
            if (!ok) { k0 = (u32x4){0u, 0u, 0u, 0u}; k1 = k0; v0 = k0; v1 = k0; }
            if (live) {
                *(LAS u32x4*)(KS + kc * LP + grp * 16) = k0; *(LAS u32x4*)(KS + kc * LP + grp * 16 + 8) = k1;
#pragma unroll
                for (int q = 0; q < 4; ++q) { VT[(grp * 16 + 2 * q) * VP + kc] = (bf16_t)(v0[q] & 0xffffu); VT[(grp * 16 + 2 * q + 1) * VP + kc] = (bf16_t)(v0[q] >> 16);
                    VT[(grp * 16 + 8 + 2 * q) * VP + kc] = (bf16_t)(v1[q] & 0xffffu); VT[(grp * 16 + 8 + 2 * q + 1) * VP + kc] = (bf16_t)(v1[q] >> 16); }
            }
        }
        {
            const int qi = (t >> 2) & 63, gq = t >> 8;
            const u32x4 r0 = qq[it][0], r1 = qq[it][1];
            float x[16];
#pragma unroll
            for (int q = 0; q < 4; ++q) { x[2 * q] = bflo(r0[q]); x[2 * q + 1] = bfhi(r0[q]); x[8 + 2 * q] = bflo(r1[q]); x[8 + 2 * q + 1] = bfhi(r1[q]); }
            if (grp == 0) {
#pragma unroll
                for (int i = 0; i < 8; ++i) { const float cs = tq[it][i >> 2][i & 3], sn = tq[it][2 + (i >> 2)][i & 3]; const float x1 = x[i], x2 = x[i + 8]; x[i] = x1 * cs - x2 * sn; x[i + 8] = x2 * cs + x1 * sn; }
            }
            u32x4 o0, o1;
#pragma unroll
            for (int q = 0; q < 4; ++q) { o0[q] = cvt_pk_bf16(x[2 * q] * 0.125f, x[2 * q + 1] * 0.125f); o1[q] = cvt_pk_bf16(x[8 + 2 * q] * 0.125f, x[8 + 2 * q + 1] * 0.125f); }
            *(LAS u32x4*)(QS + (gq * 64 + qi) * LP + grp * 16) = o0; *(LAS u32x4*)(QS + (gq * 64 + qi) * LP + grp * 16 + 8) = o1;
        }
    }
    __syncthreads();
    const int g = wave >> 1;
    const float sink = a.sinks[kvh * 4 + g];
    constexpr float LOG2E = 1.4426950408889634f;
#pragma unroll 1
    for (int rr = 0; rr < 2; ++rr) {
        const int rt = 2 * (wave & 1) + rr;
        const bf16x8 bq0 = *(const LAS bf16x8*)(QS + (g * 64 + 16 * rt + fr) * LP + 8 * fq), bq1 = *(const LAS bf16x8*)(QS + (g * 64 + 16 * rt + fr) * LP + 32 + 8 * fq);
        f32x4 s[9];
#pragma unroll
        for (int t = 0; t < 9; ++t) {
            const LAS bf16_t* kp = KS + (16 * (rt + t) + fr) * LP + 8 * fq;
            const bf16x8 k0 = *(const LAS bf16x8*)kp, k1 = *(const LAS bf16x8*)(kp + 32);
            f32x4 v = (f32x4){0.f, 0.f, 0.f, 0.f};
            v = MFMA16(k0, bq0, v); v = MFMA16(k1, bq1, v); s[t] = v;
        }
#pragma unroll
        for (int i = 0; i < 4; ++i) { if (!(4 * fq + i > fr)) s[0][i] = -INFINITY; if (!(4 * fq + i <= fr)) s[8][i] = -INFINITY; }
        if (q0 < 128) {
#pragma unroll
            for (int t = 0; t < 9; ++t)
#pragma unroll
                for (int i = 0; i < 4; ++i) { if (q0 - 128 + 16 * (rt + t) + 4 * fq + i < 0) s[t][i] = -INFINITY; }
        }
        float mx = sink;
#pragma unroll
        for (int t = 0; t < 9; ++t) mx = fmaxf(mx, fmaxf(fmaxf(s[t][0], s[t][1]), fmaxf(s[t][2], s[t][3])));
        mx = fmaxf(mx, __shfl_xor(mx, 16)); mx = fmaxf(mx, __shfl_xor(mx, 32));
        const float nmx2 = -mx * LOG2E;
        float sum = 0.f;
#pragma unroll
        for (int t = 0; t < 9; ++t)
#pragma unroll
            for (int i = 0; i < 4; ++i) { const float p = __builtin_amdgcn_exp2f(__builtin_fmaf(s[t][i], LOG2E, nmx2)); s[t][i] = p; sum += p; }
        sum += __shfl_xor(sum, 16); sum += __shfl_xor(sum, 32);
        const float inv = __builtin_amdgcn_rcpf(sum + __builtin_amdgcn_exp2f(__builtin_fmaf(sink, LOG2E, nmx2)));
        bf16x8 pf[5];
#pragma unroll
        for (int ks = 0; ks < 5; ++ks) {
            u32x4 w; w.x = cvt_pk_bf16(s[2 * ks][0], s[2 * ks][1]); w.y = cvt_pk_bf16(s[2 * ks][2], s[2 * ks][3]);
            if (ks < 4) { w.z = cvt_pk_bf16(s[2 * ks + 1][0], s[2 * ks + 1][1]); w.w = cvt_pk_bf16(s[2 * ks + 1][2], s[2 * ks + 1][3]); } else { w.z = 0u; w.w = 0u; }
            pf[ks] = __builtin_bit_cast(bf16x8, w);
        }
        f32x4 o[4];
#pragma unroll
        for (int dt = 0; dt < 4; ++dt) {
            f32x4 acc = (f32x4){0.f, 0.f, 0.f, 0.f};
            const LAS bf16_t* vp = VT + (16 * dt + fr) * VP + 16 * rt + 4 * fq;
#pragma unroll
            for (int ks = 0; ks < 5; ++ks) {
                u32x4 w; const u32x2 lo = *(const LAS u32x2*)(vp + 32 * ks); w.x = lo.x; w.y = lo.y;
                if (ks < 4) { const u32x2 hi2 = *(const LAS u32x2*)(vp + 32 * ks + 16); w.z = hi2.x; w.w = hi2.y; } else { w.z = 0u; w.w = 0u; }
                acc = MFMA16(__builtin_bit_cast(bf16x8, w), pf[ks], acc);
            }
            o[dt] = acc;
        }
        bf16_t* op = HO + (rowbase + q0 + 16 * rt + fr) * DM + 512 + (kvh * 4 + g) * 64 + 4 * fq;
#pragma unroll
        for (int dt = 0; dt < 4; ++dt) { u32x2 w; w.x = cvt_pk_bf16(o[dt][0] * inv, o[dt][1] * inv); w.y = cvt_pk_bf16(o[dt][2] * inv, o[dt][3] * inv); *(u32x2*)(op + 16 * dt) = w; }
    }
    __syncthreads();
}

#define XB_TMO      128
#define XB_XCNT(j)  (256  + 64 * (j))
#define XB_XSUB(j)  (1280 + 64 * (j))
#define XB_XGEN(j)  (2304 + 64 * (j))
#define XB_TOP      3328
#define XB_TOPGEN   3392
#define XCD_BAR_WORDS 3456
#define XB_SPIN_CAP (1u << 18)
__device__ __forceinline__ unsigned xb_ld(unsigned* p)              { return __hip_atomic_load(p, __ATOMIC_RELAXED, __HIP_MEMORY_SCOPE_AGENT); }
__device__ __forceinline__ unsigned xb_add(unsigned* p, unsigned v) { return __hip_atomic_fetch_add(p, v, __ATOMIC_RELAXED, __HIP_MEMORY_SCOPE_AGENT); }
__device__ __forceinline__ unsigned xb_xcc_id() { return (unsigned)__builtin_amdgcn_s_getreg((3 << 11) | 20) & 0xFu; }
#define XB_SPIN(cond, bar) do { unsigned _sp = 0; while (cond) { __builtin_amdgcn_s_sleep(1); \
    if ((++_sp & 255u) == 0u) { if (xb_ld(&(bar)[XB_TMO])) break; if (_sp > XB_SPIN_CAP) { atomicAdd(&(bar)[XB_TMO], 1u); break; } } } } while (0)
struct XcdBarrier { unsigned* bar; unsigned x; volatile LAS unsigned* st; };
__device__ __forceinline__ XcdBarrier xcd_barrier_post(unsigned* bar, volatile LAS unsigned* st) {
    XcdBarrier b; b.bar = bar; b.x = xb_xcc_id(); b.st = st;
    if (threadIdx.x == 0) (void)xb_add(&bar[XB_XCNT(b.x)], 1u);
    return b;
}
__device__ __forceinline__ void xcd_barrier_complete(unsigned* bar, unsigned x, unsigned& nloc, unsigned& nx) {
    const unsigned G = gridDim.x * gridDim.y * gridDim.z;
    unsigned sum, cnt, mine, sp = 0u;
    for (;;) {
        sum = 0u; cnt = 0u; mine = 0u;
#pragma unroll
        for (unsigned j = 0; j < 16; ++j) { const unsigned c = xb_ld(&bar[XB_XCNT(j)]); sum += c; cnt += (c > 0u) ? 1u : 0u; mine = (j == x) ? c : mine; }
        if (sum == G) break;
        __builtin_amdgcn_s_sleep(1);
        if ((++sp & 255u) == 0u) { if (xb_ld(&bar[XB_TMO])) break; if (sp > XB_SPIN_CAP) { atomicAdd(&bar[XB_TMO], 1u); break; } }
    }
    nloc = mine > 0u ? mine : 1u; nx = cnt > 0u ? cnt : 1u;
}
__device__ __forceinline__ void xcd_barrier(const XcdBarrier& b) {
    asm volatile("s_waitcnt vmcnt(0)" ::: "memory");
    __syncthreads();
    if (threadIdx.x == 0) {
        unsigned* bar = b.bar;
        __builtin_amdgcn_s_waitcnt(0);
        unsigned nloc = b.st[0], nx = b.st[1];
        if (nloc == 0u) { xcd_barrier_complete(bar, b.x, nloc, nx); b.st[0] = nloc; b.st[1] = nx; }
        const unsigned old = xb_add(&bar[XB_XSUB(b.x)], 1u);
        const unsigned gen = old / nloc;
        if (old + 1u == (gen + 1u) * nloc) {
            __builtin_amdgcn_fence(__ATOMIC_RELEASE, "agent");
            asm volatile("s_waitcnt vmcnt(0)" ::: "memory");
            const unsigned og = xb_add(&bar[XB_TOP], 1u);
            const unsigned tg = og / nx;
            if (og + 1u == (tg + 1u) * nx) xb_add(&bar[XB_TOPGEN], 1u);
            else XB_SPIN(xb_ld(&bar[XB_TOPGEN]) == tg, bar);
            __builtin_amdgcn_fence(__ATOMIC_ACQUIRE, "agent");
            xb_add(&bar[XB_XGEN(b.x)], 1u);
            asm volatile("s_waitcnt vmcnt(0)" ::: "memory");
        } else {
            XB_SPIN(xb_ld(&bar[XB_XGEN(b.x)]) == gen, bar);
            __builtin_amdgcn_fence(__ATOMIC_ACQUIRE, "agent");
            asm volatile("s_waitcnt vmcnt(0)" ::: "memory");
        }
    }
    __syncthreads();
}

__device__ __forceinline__ void xcd_local_barrier(unsigned* xl, unsigned x) {
    asm volatile("s_waitcnt vmcnt(0)" ::: "memory");
    __syncthreads();
    if (threadIdx.x == 0) {
        __builtin_amdgcn_s_waitcnt(0);
        unsigned* sub = xl + 512 + 64 * x; unsigned* gen = xl + 1024 + 64 * x;
        const unsigned old = xb_add(sub, 1u), g = old / 32u;
        if (old + 1u == (g + 1u) * 32u) (void)xb_add(gen, 1u);
        else { unsigned sp = 0; while (xb_ld(gen) == g) { __builtin_amdgcn_s_sleep(1); if (++sp > (1u << 22)) break; } }
        __builtin_amdgcn_fence(__ATOMIC_ACQUIRE, "agent");
        asm volatile("s_waitcnt vmcnt(0)" ::: "memory");
    }
    __syncthreads();
}

constexpr int N_PHASES = 11;
__global__ void __launch_bounds__(NWAVES * 64, 2) fwd_megakernel(Args args) {
    extern __shared__ __attribute__((aligned(16))) unsigned char lds_raw[];
    LAS unsigned char* lds = (LAS unsigned char*)lds_raw;
    cg::grid_group grid = cg::this_grid();
    const int tid = threadIdx.x, lane = tid & 63, wave = __builtin_amdgcn_readfirstlane(tid >> 6);
    const int G = gridDim.x, bx = blockIdx.x;
    const int gw = bx * NWAVES + wave, NGW = G * NWAVES;
    unsigned char* ws = args.ws;
    float* ss0 = (float*)(ws + WS_SS); float* ss1 = ss0 + M; float* ss2 = ss1 + M; float* ss3 = ss2 + M;
    const int lo = args.ph_lo, hi = args.ph_hi;
    LAS float* rsl = (LAS float*)(lds + RING_BYTES);
    if (tid < 4) ((LAS unsigned*)(lds + LDS_BARW))[tid] = 0u;
    for (unsigned i = (unsigned)(bx * (NWAVES * 64) + tid); i < (unsigned)(CTL_USED_BYTES / 16); i += (unsigned)(G * NWAVES * 64)) ((u32x4*)(ws + WS_CTL))[i] = (u32x4){0u, 0u, 0u, 0u};
    grid.sync();
    const XcdBarrier xbar = xcd_barrier_post((unsigned*)(ws + WS_CTL), (volatile LAS unsigned*)(lds + LDS_BARW));
    unsigned* xl = (unsigned*)(ws + WS_XL);
    const int myx = (int)(xbar.x & 7u);
    if (tid == 0) ((LAS unsigned*)(lds + LDS_BARW))[4] = __hip_atomic_fetch_add(xl + 64 * myx, 1u, __ATOMIC_RELAXED, __HIP_MEMORY_SCOPE_AGENT);
    __syncthreads();
    const int myrank = (int)((volatile LAS unsigned*)(lds + LDS_BARW))[4];
#ifndef PH_MASK
#define PH_MASK 0x7ff
#endif
#define IN(k) (((PH_MASK >> (k)) & 1) && lo <= (k) && (k) < hi)
#define SEAM(k) do { if (IN(k) && IN((k) + 1)) xcd_barrier(xbar); } while (0)
#define LSEAM() do { if (xlmode) xcd_local_barrier(xl, (unsigned)myx); else xcd_barrier(xbar); } while (0)

    if (IN(0)) { p0_prologue(args, lds, gw, NGW, wave, lane); }
    SEAM(0);
    bool xlmode = (G == 256);
#pragma unroll
    for (int x = 0; x < 8; ++x) xlmode = xlmode && (__hip_atomic_load(xl + 64 * x, __ATOMIC_RELAXED, __HIP_MEMORY_SCOPE_AGENT) == 32u);
    const int cu = xlmode ? myrank * 8 + myx : bx;
    unsigned char* actb = ws + WS_ACT + (xlmode ? (size_t)myx * (size_t)(4096 * (NIN - DFF) * 2) : (size_t)0);
    if (IN(1)) {
        pg8::Gemm g{(const bf16_t*)(ws + WS_XB), (const bf16_t*)(ws + WS_W1GU), DM, DM, DM}; pg8::StaticOrder S; S.init(M, NGU, G, cu);
        pg8::EpiSwiGLU E{(bf16_t*)actb, rsl};
        pg8::gemm_phase<pg8::EpiSwiGLU, pg8::StaticOrder, true>(lds, g, S, E, ss0, rsl);
    }
    LSEAM();
    if (IN(2)) {
        pg8::Gemm g{(const bf16_t*)actb, (const bf16_t*)(ws + WS_W1D), DFF, DFF, DFF}; pg8::StaticOrder S; S.init(M, DM, G, cu);
        pg8::EpiResid<true> E{(const void*)(ws + WS_XB), (bf16_t*)(ws + WS_XB), ss1, 0.5f};
        pg8::gemm_phase<pg8::EpiResid<true>, pg8::StaticOrder, true>(lds, g, S, E);
    }
    LSEAM();
    if (IN(3)) {
        pg8::Gemm g{(const bf16_t*)(ws + WS_XB), (const bf16_t*)(ws + WS_WIN), DM, DM, DM}; pg8::StaticOrder S; S.init(M, NIN, G, cu);
        pg8::EpiInProj E{(bf16_t*)(ws + WS_ACT), (float*)(ws + WS_GATES), rsl};
        pg8::gemm_phase<pg8::EpiInProj, pg8::StaticOrder, true>(lds, g, S, E, ss1, rsl);
    }
    LSEAM();
    if (IN(4)) {
        if (xlmode) {
            if (myrank < 24) { const int b = 2 * myx + myrank / 12, rem = myrank % 12; mlstm_state_group(args, lds, b * 4 + rem / 3, rem % 3, tid, wave, lane); }
            for (int k = 0; k < 4; ++k) { const int l = myrank + 32 * k; attn_item(args, lds, ((2 * myx + (l >> 6)) << 6) | (l & 63), tid, wave, lane); }
        } else {
        for (int it = bx; it < 64 * 3; it += G) mlstm_state_group(args, lds, it / 3, it % 3, tid, wave, lane);
        for (int it = bx; it < 1024; it += G) attn_item(args, lds, it, tid, wave, lane);
        }
    }
    LSEAM();
    if (IN(10)) {
        if (xlmode) { const int b = 2 * myx + (myrank >> 4); mlstm_group<false>(args, lds, b * 4 + ((myrank >> 2) & 3), myrank & 3, tid, wave, lane); }
        else for (int it = bx; it < 256; it += G) mlstm_group<false>(args, lds, it >> 2, it & 3, tid, wave, lane);
    }
    LSEAM();
    if (IN(5)) {
        pg8::Gemm g{(const bf16_t*)(ws + WS_HO), (const bf16_t*)(ws + WS_WBR), DM, DM, DM}; pg8::StaticOrder S; S.init(M, DM, G, cu);
        pg8::EpiMerge E{(const bf16_t*)(ws + WS_ACT), (bf16_t*)args.out, 2 * DM};
        pg8::gemm_phase<pg8::EpiMerge, pg8::StaticOrder, true>(lds, g, S, E);
    }
    LSEAM();
    if (IN(6)) {
        pg8::Gemm g{(const bf16_t*)args.out, (const bf16_t*)(ws + WS_WO), 2 * DM, DM, DM}; pg8::StaticOrder S; S.init(M, DM, G, cu);
        pg8::EpiResid<true> E{(const void*)(ws + WS_XB), (bf16_t*)(ws + WS_HO), ss2, 1.0f};
        pg8::gemm_phase<pg8::EpiResid<true>, pg8::StaticOrder, true>(lds, g, S, E);
    }
    LSEAM();
    if (IN(7)) {
        pg8::Gemm g{(const bf16_t*)(ws + WS_HO), (const bf16_t*)(ws + WS_W2GU), DM, DM, DM}; pg8::StaticOrder S; S.init(M, NGU, G, cu);
        pg8::EpiSwiGLU E{(bf16_t*)actb, rsl};
        pg8::gemm_phase<pg8::EpiSwiGLU, pg8::StaticOrder, true>(lds, g, S, E, ss2, rsl);
    }
    LSEAM();
    if (IN(8)) {
        pg8::Gemm g{(const bf16_t*)actb, (const bf16_t*)(ws + WS_W2D), DFF, DFF, DFF}; pg8::StaticOrder S; S.init(M, DM, G, cu);
        pg8::EpiFinal E{(const bf16_t*)(ws + WS_HO), args.out, ss3, (unsigned*)(ws + WS_PCNT), args.gfin, 0.5f};
        pg8::gemm_phase<pg8::EpiFinal, pg8::StaticOrder, true>(lds, g, S, E);
    }
#undef IN
#undef SEAM
}

extern "C" void kernel_launch(void* const* d_in, const int* in_sizes, int n_in, void* d_out, int out_size, void* d_ws, size_t ws_size, hipStream_t stream) {
    static int grid = 0;
    if (grid == 0) {
        if (n_in != 20 || in_sizes[0] != M * DM || out_size != M * DM || ws_size < WS_END) { fprintf(stderr, "kernel_launch: unexpected shapes (n_in %d, in0 %d, out %d, ws %zu)\n", n_in, n_in > 0 ? in_sizes[0] : -1, out_size, ws_size); grid = -1; return; }
        int dev = 0, cus = 0, per_cu = 0;
        if (hipGetDevice(&dev) != hipSuccess || hipDeviceGetAttribute(&cus, hipDeviceAttributeMultiprocessorCount, dev) != hipSuccess) { grid = -1; return; }
        if (hipFuncSetAttribute((const void*)fwd_megakernel, hipFuncAttributeMaxDynamicSharedMemorySize, LDS_BYTES) != hipSuccess) { fprintf(stderr, "kernel_launch: hipFuncSetAttribute failed\n"); grid = -1; return; }
        if (hipOccupancyMaxActiveBlocksPerMultiprocessor(&per_cu, (const void*)fwd_megakernel, NWAVES * 64, LDS_BYTES) != hipSuccess || per_cu < 1) { fprintf(stderr, "kernel_launch: occupancy query gave %d\n", per_cu); (void)hipGetLastError(); grid = -1; return; }
        grid = cus;
    }
    if (grid < 0) return;
    Args a{};
    a.x = (const float*)d_in[0]; a.pos = (const int*)d_in[1];
    a.g1 = (const float*)d_in[2]; a.w1g = (const float*)d_in[3]; a.w1u = (const float*)d_in[4]; a.w1d = (const float*)d_in[5];
    a.gmix = (const float*)d_in[6]; a.win = (const float*)d_in[7]; a.bi = (const float*)d_in[8]; a.bf = (const float*)d_in[9];
    a.gno = (const float*)d_in[10]; a.sinks = (const float*)d_in[11]; a.wbm = (const float*)d_in[12]; a.wba = (const float*)d_in[13]; a.wo = (const float*)d_in[14];
    a.g2 = (const float*)d_in[15]; a.w2g = (const float*)d_in[16]; a.w2u = (const float*)d_in[17]; a.w2d = (const float*)d_in[18]; a.gfin = (const float*)d_in[19];
    a.out = (float*)d_out; a.ws = (unsigned char*)d_ws; a.ph_lo = 0; a.ph_hi = N_PHASES;
    void* kargs[] = {&a};
    hipError_t e = hipLaunchCooperativeKernel((const void*)fwd_megakernel, dim3(grid), dim3(NWAVES * 64), kargs, LDS_BYTES, stream);
    if (e != hipSuccess) fprintf(stderr, "kernel_launch: cooperative launch failed: %s (grid %d)\n", hipGetErrorString(e), grid);
}
```

```cpp
#include <hip/hip_runtime.h>
#include <hip/hip_cooperative_groups.h>
#include <cstdio>
#include <cstdint>
namespace cg = cooperative_groups;

#define LAS __attribute__((address_space(3)))
typedef unsigned short bf16_t;
typedef short bf16x8 __attribute__((ext_vector_type(8)));
typedef float f32x4 __attribute__((ext_vector_type(4)));
typedef float f32x2 __attribute__((ext_vector_type(2)));
typedef unsigned u32x4 __attribute__((ext_vector_type(4)));
typedef unsigned u32x2 __attribute__((ext_vector_type(2)));

constexpr int BATCH = 16, SEQ = 2048, DM = 1024, M = BATCH * SEQ, DFF = 2816, NGU = 2 * DFF;
constexpr int NIN = 4608;
constexpr int WIN_SRC = 4360;
constexpr int PC_QM = 0, PC_KM = 256, PC_VM = 512, PC_OM = 1024, PC_QA = 1536, PC_KA = 2048, PC_VA = 2176, PC_GM = 2304, PC_GA = 3328;
constexpr float NORM_EPS = 1e-6f;
constexpr int NWAVES = 8;

constexpr size_t MiB = 1u << 20;
constexpr size_t WS_CTL = 0, CTL_USED_BYTES = 64 * 1024 + 4 * 131072;
constexpr size_t WS_PCNT = 16 * 1024;
constexpr size_t WS_XL = 50 * 1024;
constexpr size_t WS_SS = 64 * 1024;
constexpr size_t WS_W1GU = 1 * MiB, WS_W1D = 12 * MiB, WS_WIN = 18 * MiB, WS_WBR = 27 * MiB, WS_WO = 29 * MiB, WS_W2GU = 31 * MiB, WS_W2D = 42 * MiB;
constexpr size_t WS_GATES = 48 * MiB;
constexpr size_t WS_ROPE = 49 * MiB;
constexpr size_t WS_XB = 56 * MiB;
constexpr size_t WS_ACT = 120 * MiB;
constexpr size_t WS_HO = 408 * MiB;
constexpr size_t WS_CG = 472 * MiB;
constexpr size_t WS_NG = 480 * MiB;
constexpr size_t WS_SG = WS_NG + 64 * 4 * 64 * 4;
constexpr size_t WS_CHS = WS_SG + 64 * 4 * 2 * 4;
constexpr size_t WS_END = 481 * MiB;

constexpr int RING_BYTES = 131072;
constexpr int LDS_BYTES = 147456;
constexpr int LDS_BARW = LDS_BYTES - 64;

__device__ __forceinline__ unsigned cvt_pk_bf16(float lo, float hi) { unsigned r; asm volatile("v_cvt_pk_bf16_f32 %0, %1, %2" : "=v"(r) : "v"(lo), "v"(hi)); return r; }
__device__ __forceinline__ bf16_t f2bf(float f) { return (bf16_t)(cvt_pk_bf16(f, 0.f) & 0xffffu); }
__device__ __forceinline__ float bf2f(unsigned short h) { return __uint_as_float(((unsigned)h) << 16); }
__device__ __forceinline__ float bflo(unsigned w) { return __uint_as_float(w << 16); }
__device__ __forceinline__ float bfhi(unsigned w) { return __uint_as_float(w & 0xffff0000u); }
__device__ __forceinline__ float sigm(float x) { return __builtin_amdgcn_rcpf(1.f + __expf(-x)); }
__device__ __forceinline__ float wave_sum(float v) {
#pragma unroll
    for (int o = 1; o < 64; o <<= 1) v += __shfl_xor(v, o);
    return v;
}
#define LDS_WAIT() asm volatile("s_waitcnt lgkmcnt(0)" ::: "memory")

namespace pg8 {
constexpr int BM = 256, BK = 64, HALF = 128, HTB = HALF * BK * 2, STAGE_BYTES = 8 * HTB, NXCD = 8, WGM = 4;
__host__ __device__ __forceinline__ int lds_byte(int r, int c) { const int st = (r >> 4) * 2 + (c >> 5), rr = r & 15, cc = c & 31, ob = rr * 64 + cc * 2; return st * 1024 + (ob ^ (((ob >> 9) & 1) << 5)); }
__host__ __device__ __forceinline__ void stage_rc(int b, int& R, int& C) { const int st = b / 1024, sb = b % 1024, swz = sb ^ (((sb >> 9) & 1) << 5); R = (st >> 1) * 16 + swz / 64; C = (st & 1) * 32 + (swz % 64) / 2; }
__host__ __device__ __forceinline__ int perm32(int rho) { const int n = rho >> 4, i = rho & 15; return 8 * (i >> 2) + 4 * n + (i & 3); }

struct Unit { int pm, pn, idx; };
struct Gemm { const bf16_t* A; const bf16_t* Bt; int lda, ldb, K; };

struct StaticOrder {
    int nM, nN, nwg, G, c;
    __host__ __device__ void init(int M_, int N_, int G_, int c_) { nM = M_ / BM; nN = N_ / BM; nwg = nM * nN; G = G_; c = c_; }
    __host__ __device__ bool next(int i, Unit& u) const {
        const long L = (long)i * G + c; if (L >= nwg) return false;
        int wgid = (int)L; { const int q = nwg / NXCD, r = nwg % NXCD, xcd = wgid % NXCD, off = wgid / NXCD; wgid = (xcd < r ? xcd * (q + 1) : r * (q + 1) + (xcd - r) * q) + off; }
        const int nig = WGM * nN, gid = wgid / nig, fm = gid * WGM, gsz = (nM - fm) < WGM ? (nM - fm) : WGM;
        u.pm = fm + ((wgid % nig) % gsz); u.pn = (wgid % nig) / gsz; u.idx = i; return true;
    }
};

typedef f32x4 Acc[2][2][4][2];

struct EpiSwiGLU {
    static constexpr int MID_T = -1;
    bf16_t* O; const LAS float* rs;
    __device__ __forceinline__ void mid(Acc&, const Unit&, int, int, int, int) const {}
    __device__ __forceinline__ void operator()(Acc& acc, const Unit& u, int wr, int wc, int fr, int fq) const {
        const int row0 = u.pm * BM + wr * 64 + fr, col0 = u.pn * 128 + wc * 32 + 8 * fq;
#pragma unroll
        for (int ai = 0; ai < 2; ++ai)
#pragma unroll
            for (int m = 0; m < 4; ++m) {
                const int row = row0 + ai * HALF + m * 16;
                const float r = rs[u.idx * BM + wr * 64 + fr + ai * HALF + m * 16];
                const float c1 = -r * 1.4426950408889634f, r2 = r * r;
                f32x4 o[2];
#pragma unroll
                for (int n = 0; n < 2; ++n) {
                    const f32x4 g = acc[ai][0][m][n], up = acc[ai][1][m][n];
                    const f32x4 t = g * c1; f32x4 e;
#pragma unroll
                    for (int i = 0; i < 4; ++i) e[i] = __builtin_amdgcn_exp2f(t[i]);
                    const f32x4 d = e + 1.0f; f32x4 q;
#pragma unroll
                    for (int i = 0; i < 4; ++i) q[i] = __builtin_amdgcn_rcpf(d[i]);
                    o[n] = (g * up) * (q * r2);
                }
                u32x4 w; w.x = cvt_pk_bf16(o[0][0], o[0][1]); w.y = cvt_pk_bf16(o[0][2], o[0][3]); w.z = cvt_pk_bf16(o[1][0], o[1][1]); w.w = cvt_pk_bf16(o[1][2], o[1][3]);
                *(u32x4*)(O + (size_t)row * DFF + col0) = w;
            }
    }
};
template <bool BASE_BF16> struct EpiResid {
    static constexpr int MID_T = -1;
    const void* base; bf16_t* xb; float* ss; float scale;
    __device__ __forceinline__ void mid(Acc&, const Unit&, int, int, int, int) const {}
    __device__ __forceinline__ void operator()(Acc& acc, const Unit& u, int wr, int wc, int fr, int fq) const {
        const int row0 = u.pm * BM + wr * 64 + fr, col0 = u.pn * BM + wc * 32 + 8 * fq;
#pragma unroll
        for (int ai = 0; ai < 2; ++ai)
#pragma unroll
            for (int m = 0; m < 4; ++m) {
                const int row = row0 + ai * HALF + m * 16; float sq = 0.f;
#pragma unroll
                for (int bj = 0; bj < 2; ++bj) {
                    const size_t p = (size_t)row * DM + col0 + bj * HALF;
                    f32x4 b0, b1;
                    if constexpr (BASE_BF16) { const u32x4 w = *(const u32x4*)((const bf16_t*)base + p); b0 = (f32x4){bflo(w.x), bfhi(w.x), bflo(w.y), bfhi(w.y)}; b1 = (f32x4){bflo(w.z), bfhi(w.z), bflo(w.w), bfhi(w.w)}; }
                    else { b0 = *(const f32x4*)((const float*)base + p); b1 = *(const f32x4*)((const float*)base + p + 4); }
                    const f32x4 v0 = b0 + acc[ai][bj][m][0] * scale, v1 = b1 + acc[ai][bj][m][1] * scale;
                    u32x4 w; w.x = cvt_pk_bf16(v0[0], v0[1]); w.y = cvt_pk_bf16(v0[2], v0[3]); w.z = cvt_pk_bf16(v1[0], v1[1]); w.w = cvt_pk_bf16(v1[2], v1[3]); *(u32x4*)(xb + p) = w;
                    sq += (v0[0] * v0[0] + v0[1] * v0[1]) + (v0[2] * v0[2] + v0[3] * v0[3]) + (v1[0] * v1[0] + v1[1] * v1[1]) + (v1[2] * v1[2] + v1[3] * v1[3]);
                }
                sq += __shfl_xor(sq, 16); sq += __shfl_xor(sq, 32);
                if (fq == 0) atomicAdd(ss + row, sq);
            }
    }
};
struct EpiFinal {
    static constexpr int MID_T = -1;
    const bf16_t* base; float* out; float* ss; unsigned* cnt; const float* gain; float scale;
    __device__ __forceinline__ void mid(Acc&, const Unit&, int, int, int, int) const {}
    __device__ __forceinline__ void operator()(Acc& acc, const Unit& u, int wr, int wc, int fr, int fq) const {
        const int row0 = u.pm * BM + wr * 64 + fr, col0 = u.pn * BM + wc * 32 + 8 * fq;
#pragma unroll
        for (int ai = 0; ai < 2; ++ai)
#pragma unroll
            for (int m = 0; m < 4; ++m) {
                const int row = row0 + ai * HALF + m * 16; float sq = 0.f;
#pragma unroll
                for (int bj = 0; bj < 2; ++bj) {
                    const size_t p = (size_t)row * DM + col0 + bj * HALF;
                    const u32x4 w = *(const u32x4*)(base + p);
                    const f32x4 v0 = (f32x4){bflo(w.x), bfhi(w.x), bflo(w.y), bfhi(w.y)} + acc[ai][bj][m][0] * scale, v1 = (f32x4){bflo(w.z), bfhi(w.z), bflo(w.w), bfhi(w.w)} + acc[ai][bj][m][1] * scale;
                    acc[ai][bj][m][0] = v0; acc[ai][bj][m][1] = v1;
                    sq += (v0[0] * v0[0] + v0[1] * v0[1]) + (v0[2] * v0[2] + v0[3] * v0[3]) + (v1[0] * v1[0] + v1[1] * v1[1]) + (v1[2] * v1[2] + v1[3] * v1[3]);
                }
                sq += __shfl_xor(sq, 16); sq += __shfl_xor(sq, 32);
                if (fq == 0) atomicAdd(ss + row, sq);
            }
        asm volatile("s_waitcnt vmcnt(0)" ::: "memory");
        unsigned* c = cnt + 64 * u.pm;
        if ((threadIdx.x & 63) == 0) __hip_atomic_fetch_add(c, 1u, __ATOMIC_RELAXED, __HIP_MEMORY_SCOPE_AGENT);
        const f32x4 g00 = *(const f32x4*)(gain + col0), g01 = *(const f32x4*)(gain + col0 + 4), g10 = *(const f32x4*)(gain + col0 + HALF), g11 = *(const f32x4*)(gain + col0 + HALF + 4);
        { unsigned sp = 0; while (__hip_atomic_load(c, __ATOMIC_RELAXED, __HIP_MEMORY_SCOPE_AGENT) < 32u) { __builtin_amdgcn_s_sleep(2); if (++sp > (1u << 22)) break; } }
        asm volatile("" ::: "memory");
        float rr[2][4];
#pragma unroll
        for (int ai = 0; ai < 2; ++ai)
#pragma unroll
            for (int m = 0; m < 4; ++m) rr[ai][m] = __hip_atomic_load(ss + row0 + ai * HALF + m * 16, __ATOMIC_RELAXED, __HIP_MEMORY_SCOPE_AGENT);
#pragma unroll
        for (int ai = 0; ai < 2; ++ai)
#pragma unroll
            for (int m = 0; m < 4; ++m) {
                const int row = row0 + ai * HALF + m * 16;
                const float r = rsqrtf(rr[ai][m] * (1.0f / DM) + NORM_EPS);
                float* op = out + (size_t)row * DM + col0;
                *(f32x4*)op = acc[ai][0][m][0] * r * g00; *(f32x4*)(op + 4) = acc[ai][0][m][1] * r * g01;
                *(f32x4*)(op + HALF) = acc[ai][1][m][0] * r * g10; *(f32x4*)(op + HALF + 4) = acc[ai][1][m][1] * r * g11;
            }
    }
};
struct EpiInProj {
    static constexpr int MID_T = -1;
    bf16_t* P; float* gates; const LAS float* rs;
    __device__ __forceinline__ void mid(Acc&, const Unit&, int, int, int, int) const {}
    __device__ __forceinline__ void operator()(Acc& acc, const Unit& u, int wr, int wc, int fr, int fq) const {
        const int row0 = u.pm * BM + wr * 64 + fr, col0 = u.pn * BM + wc * 32 + 8 * fq;
        const bool gate_tile = (u.pn == 17);
#pragma unroll
        for (int ai = 0; ai < 2; ++ai)
#pragma unroll
            for (int m = 0; m < 4; ++m) {
                const int row = row0 + ai * HALF + m * 16;
                const float r = rs[u.idx * BM + wr * 64 + fr + ai * HALF + m * 16];
                if (gate_tile) {
                    if (wc == 0 && fq == 0) { *(f32x4*)(gates + (size_t)row * 8) = acc[ai][0][m][0] * r; *(f32x4*)(gates + (size_t)row * 8 + 4) = acc[ai][0][m][1] * r; }
                } else if (u.pn >= 9) {
                    const float c1 = -r * 1.4426950408889634f;
                    f32x4 R[2], S[2];
#pragma unroll
                    for (int n = 0; n < 2; ++n) {
                        const f32x4 tm = acc[ai][0][m][n] * c1, ta = acc[ai][1][m][n] * c1; f32x4 em, ea;
#pragma unroll
                        for (int i = 0; i < 4; ++i) { em[i] = __builtin_amdgcn_exp2f(tm[i]); ea[i] = __builtin_amdgcn_exp2f(ta[i]); }
                        const f32x4 dm = em + 1.0f, da = ea + 1.0f; f32x4 qm, qa;
#pragma unroll
                        for (int i = 0; i < 4; ++i) { qm[i] = __builtin_amdgcn_rcpf(dm[i]); qa[i] = __builtin_amdgcn_rcpf(da[i]); }
                        R[n] = da * qm; S[n] = qa;
                    }
                    const int gcol = (u.pn - 9) * HALF + wc * 32 + 8 * fq;
                    u32x4 w; w.x = cvt_pk_bf16(R[0][0], R[0][1]); w.y = cvt_pk_bf16(R[0][2], R[0][3]); w.z = cvt_pk_bf16(R[1][0], R[1][1]); w.w = cvt_pk_bf16(R[1][2], R[1][3]);
                    *(u32x4*)(P + (size_t)row * NIN + PC_GM + gcol) = w;
                    w.x = cvt_pk_bf16(S[0][0], S[0][1]); w.y = cvt_pk_bf16(S[0][2], S[0][3]); w.z = cvt_pk_bf16(S[1][0], S[1][1]); w.w = cvt_pk_bf16(S[1][2], S[1][3]);
                    *(u32x4*)(P + (size_t)row * NIN + PC_GA + gcol) = w;
                } else {
#pragma unroll
                    for (int bj = 0; bj < 2; ++bj) {
                        const f32x4 v0 = acc[ai][bj][m][0] * r, v1 = acc[ai][bj][m][1] * r;
                        u32x4 w; w.x = cvt_pk_bf16(v0[0], v0[1]); w.y = cvt_pk_bf16(v0[2], v0[3]); w.z = cvt_pk_bf16(v1[0], v1[1]); w.w = cvt_pk_bf16(v1[2], v1[3]);
                        *(u32x4*)(P + (size_t)row * NIN + col0 + bj * HALF) = w;
                    }
                }
            }
    }
};
struct EpiMerge {
    static constexpr int MID_T = 8;
    const bf16_t* P; bf16_t* O; int ldo;
    __device__ __forceinline__ void scale(Acc& acc, const Unit& u, int wr, int wc, int fr, int fq, int pc, bool store) const {
        int row0 = u.pm * BM + wr * 64 + fr, col0 = u.pn * BM + wc * 32 + 8 * fq;
        asm volatile("" : "+v"(row0), "+v"(col0));
        const char* Pb = (const char*)P; char* Ob = (char*)O;
#pragma unroll
        for (int ai = 0; ai < 2; ++ai) {
            u32x4 g[4][2];
#pragma unroll
            for (int m = 0; m < 4; ++m) {
                const unsigned rowoff = (unsigned)(row0 + ai * HALF + m * 16) * (unsigned)(NIN * 2) + (unsigned)col0 * 2u;
#pragma unroll
                for (int bj = 0; bj < 2; ++bj) g[m][bj] = *(const u32x4*)(Pb + (rowoff + (unsigned)((pc + bj * HALF) * 2)));
            }
#pragma unroll
            for (int m = 0; m < 4; ++m) {
                const unsigned ooff = (unsigned)(row0 + ai * HALF + m * 16) * (unsigned)(ldo * 2) + (unsigned)col0 * 2u;
#pragma unroll
                for (int bj = 0; bj < 2; ++bj) {
                    const u32x4 gg = g[m][bj];
                    const f32x4 s0 = (f32x4){bflo(gg.x), bfhi(gg.x), bflo(gg.y), bfhi(gg.y)}, s1 = (f32x4){bflo(gg.z), bfhi(gg.z), bflo(gg.w), bfhi(gg.w)};
                    const f32x4 v0 = acc[ai][bj][m][0] * s0, v1 = acc[ai][bj][m][1] * s1;
                    if (store) { u32x4 w; w.x = cvt_pk_bf16(v0[0], v0[1]); w.y = cvt_pk_bf16(v0[2], v0[3]); w.z = cvt_pk_bf16(v1[0], v1[1]); w.w = cvt_pk_bf16(v1[2], v1[3]); *(u32x4*)(Ob + (ooff + (unsigned)(bj * HALF * 2))) = w; }
                    else { acc[ai][bj][m][0] = v0; acc[ai][bj][m][1] = v1; }
                }
            }
            asm volatile("" ::: "memory");
        }
    }
    __device__ __forceinline__ void mid(Acc& acc, const Unit& u, int wr, int wc, int fr, int fq) const { scale(acc, u, wr, wc, fr, fq, PC_GM, false); }
    __device__ __forceinline__ void operator()(Acc& acc, const Unit& u, int wr, int wc, int fr, int fq) const { scale(acc, u, wr, wc, fr, fq, PC_GA, true); }
};

template <class Sched>
__device__ __forceinline__ void rstd_table(LAS float* rs, const float* ss, const Sched& S) {
    Unit u;
    for (int i = 0; i < 15 && S.next(i, u); ++i) if (threadIdx.x < BM) rs[i * BM + threadIdx.x] = rsqrtf(ss[u.pm * BM + threadIdx.x] * (1.0f / DM) + NORM_EPS);
}
template <class Epi, class Sched, bool ALIGN_EPI>
__device__ __forceinline__ void gemm_phase(LAS unsigned char* lds, const Gemm g, const Sched& S, const Epi& E, const float* pre_ss = nullptr, LAS float* pre_rs = nullptr) {
    const int tid = threadIdx.x, wid = __builtin_amdgcn_readfirstlane(tid >> 6), lane = tid & 63, wr = wid >> 2, wc = wid & 3, fr = lane & 15, fq = lane >> 4;
    const int K = g.K, nt = K / BK;
    unsigned voffA[2], voffB[2];
#pragma unroll
    for (int i = 0; i < 2; ++i) { int R, C; stage_rc(tid * 16 + i * 8192, R, C); const int Rb = (R & ~31) + perm32(R & 31);
        voffA[i] = (unsigned)(R * g.lda + C) * 2u; voffB[i] = (unsigned)(Rb * g.ldb + C) * 2u; }
    const size_t kstep = (size_t)(BK * 2);
    const size_t hstepA = (size_t)HALF * g.lda * 2, hstepB = (size_t)HALF * g.ldb * 2;
    const size_t tstepA = 2 * hstepA, tstepB = 2 * hstepB;
    const unsigned ldsw = (unsigned)wid * 1024u;
    const int aoff = lds_byte(wr * 64 + fr, fq * 8), boff = lds_byte(wc * 32 + fr, fq * 8);
#define PG8_SA(b, h) (((b) * 2 + (h)) * HTB)
#define PG8_SB(b, h) ((4 + (b) * 2 + (h)) * HTB)
#define PG8_STAGE(bufoff, gbase, voff) do { _Pragma("unroll") for (int _i = 0; _i < 2; ++_i) \
        __builtin_amdgcn_global_load_lds((const unsigned*)((const char*)(gbase) + (voff)[_i]), (LAS unsigned*)(lds + (bufoff) + ldsw + _i * 8192), 16, 0, 0); } while (0)
#define PG8_LDA(dst, b, h) do { _Pragma("unroll") for (int m = 0; m < 4; ++m) _Pragma("unroll") for (int k = 0; k < 2; ++k) dst[m][k] = *(const LAS bf16x8*)(lds + PG8_SA(b, h) + aoff + m * 2048 + k * 1024); } while (0)
#define PG8_LDB(dst, b, h) do { _Pragma("unroll") for (int n = 0; n < 2; ++n) _Pragma("unroll") for (int k = 0; k < 2; ++k) dst[n][k] = *(const LAS bf16x8*)(lds + PG8_SB(b, h) + boff + n * 2048 + k * 1024); } while (0)
#define PG8_MMA(ai, bj, At, Bt) do { __builtin_amdgcn_s_setprio(1); _Pragma("unroll") for (int m = 0; m < 4; ++m) _Pragma("unroll") for (int n = 0; n < 2; ++n) _Pragma("unroll") for (int k = 0; k < 2; ++k) \
        acc[ai][bj][m][n] = __builtin_amdgcn_mfma_f32_16x16x32_bf16(Bt[n][k], At[m][k], acc[ai][bj][m][n], 0, 0, 0); __builtin_amdgcn_s_setprio(0); } while (0)
#define PG8_WAIT_V(n) asm volatile("s_waitcnt vmcnt(" #n ")" ::: "memory")
#define PG8_WAIT_L(n) asm volatile("s_waitcnt lgkmcnt(" #n ")" ::: "memory")
#define PG8_BAR __builtin_amdgcn_s_barrier()
#define PG8_SCHED __builtin_amdgcn_sched_barrier(0)
#define PG8_KBODY(t) do { \
            const bool last = (t == nt - 2); \
            const char* a1 = cA + (size_t)(t + 1) * kstep; \
            const char* a2 = last ? nA : cA + (size_t)(t + 2) * kstep; const char* b2 = last ? nB : cB + (size_t)(t + 2) * kstep; \
            const char* a3 = a2 + kstep; const char* b3 = b2 + kstep; \
            PG8_LDB(B0, 0, 0); PG8_LDB(B1, 0, 1); PG8_SCHED; PG8_LDA(At, 0, 0); PG8_STAGE(PG8_SA(1, 1), a1 + hstepA, voffA); \
            PG8_WAIT_V(8); PG8_WAIT_L(0); PG8_BAR; PG8_MMA(0, 0, At, B0); PG8_MMA(0, 1, At, B1); PG8_BAR; PG8_SCHED; \
            PG8_LDA(At, 0, 1); PG8_STAGE(PG8_SB(0, 0), b2, voffB); PG8_STAGE(PG8_SB(0, 1), b2 + hstepB, voffB); PG8_STAGE(PG8_SA(0, 0), a2, voffA); \
            PG8_WAIT_V(8); PG8_WAIT_L(0); PG8_BAR; PG8_MMA(1, 0, At, B0); PG8_MMA(1, 1, At, B1); PG8_BAR; PG8_SCHED; \
            PG8_LDB(B0, 1, 0); PG8_LDB(B1, 1, 1); PG8_SCHED; PG8_LDA(At, 1, 0); PG8_STAGE(PG8_SA(0, 1), a2 + hstepA, voffA); \
            PG8_WAIT_V(8); PG8_WAIT_L(0); PG8_BAR; PG8_MMA(0, 0, At, B0); PG8_MMA(0, 1, At, B1); PG8_BAR; PG8_SCHED; \
            PG8_LDA(At, 1, 1); PG8_STAGE(PG8_SB(1, 0), b3, voffB); PG8_STAGE(PG8_SB(1, 1), b3 + hstepB, voffB); PG8_STAGE(PG8_SA(1, 0), a3, voffA); \
            PG8_WAIT_V(8); PG8_WAIT_L(0); PG8_BAR; PG8_MMA(1, 0, At, B0); PG8_MMA(1, 1, At, B1); PG8_BAR; PG8_SCHED; \
        } while (0)
    Unit cur, nxt; int ui = 0;
    if (!S.next(0, cur)) return;
    Acc acc;
#pragma unroll
    for (int a = 0; a < 2; ++a)
#pragma unroll
        for (int b = 0; b < 2; ++b)
#pragma unroll
            for (int m = 0; m < 4; ++m)
#pragma unroll
                for (int n = 0; n < 2; ++n) acc[a][b][m][n] = (f32x4){0.f, 0.f, 0.f, 0.f};
    bf16x8 At[4][2], B0[2][2], B1[2][2];
    const char* cA = (const char*)g.A + (size_t)cur.pm * tstepA; const char* cB = (const char*)g.Bt + (size_t)cur.pn * tstepB;
    PG8_STAGE(PG8_SB(0, 0), cB, voffB); PG8_STAGE(PG8_SB(0, 1), cB + hstepB, voffB); PG8_STAGE(PG8_SA(0, 0), cA, voffA); PG8_STAGE(PG8_SA(0, 1), cA + hstepA, voffA);
    if (pre_ss) rstd_table(pre_rs, pre_ss, S);
    if (wr == 1) PG8_BAR;
    PG8_WAIT_V(2); PG8_BAR;
    PG8_STAGE(PG8_SB(1, 0), cB + kstep, voffB); PG8_STAGE(PG8_SA(1, 0), cA + kstep, voffA); PG8_STAGE(PG8_SB(1, 1), cB + hstepB + kstep, voffB);
    PG8_WAIT_V(6); PG8_BAR;
    for (;;) {
        const bool has_next = S.next(ui + 1, nxt);
        const char* nA = has_next ? (const char*)g.A + (size_t)nxt.pm * tstepA : cA; const char* nB = has_next ? (const char*)g.Bt + (size_t)nxt.pn * tstepB : cB;
        if constexpr (Epi::MID_T >= 0) {
            for (int t = 0; t < Epi::MID_T; t += 2) PG8_KBODY(t);
            E.mid(acc, cur, wr, wc, fr, fq);
            for (int t = Epi::MID_T; t < nt; t += 2) PG8_KBODY(t);
        } else {
            for (int t = 0; t < nt; t += 2) PG8_KBODY(t);
        }
        if constexpr (ALIGN_EPI) { if (wr == 0) PG8_BAR; }
        E(acc, cur, wr, wc, fr, fq);
        if (!has_next) break;
#pragma unroll
        for (int a = 0; a < 2; ++a)
#pragma unroll
            for (int b = 0; b < 2; ++b)
#pragma unroll
                for (int m = 0; m < 4; ++m)
#pragma unroll
                    for (int n = 0; n < 2; ++n) acc[a][b][m][n] = (f32x4){0.f, 0.f, 0.f, 0.f};
        cur = nxt; cA = nA; cB = nB; ++ui;
        if constexpr (ALIGN_EPI) { if (wr == 1) PG8_BAR; }
    }
    PG8_WAIT_V(0);
    if constexpr (!ALIGN_EPI) { if (wr == 0) PG8_BAR; }
    PG8_BAR;
#undef PG8_SA
#undef PG8_SB
#undef PG8_STAGE
#undef PG8_LDA
#undef PG8_LDB
#undef PG8_MMA
#undef PG8_WAIT_V
#undef PG8_WAIT_L
#undef PG8_BAR
#undef PG8_SCHED
#undef PG8_KBODY
}
}

__device__ __forceinline__ void transpose_item(const float* colp, int N, const float* gk, bf16_t* WT, int ldw, int koff, int k0, int n0, LAS float* scr, int lane) {
    float v[32];
#pragma unroll
    for (int i = 0; i < 32; ++i) { const int kk = 2 * i + (lane >> 5); v[i] = colp ? colp[(size_t)(k0 + kk) * N] : 0.f; }
#pragma unroll
    for (int i = 0; i < 32; ++i) { const int kk = 2 * i + (lane >> 5); scr[kk * 33 + (lane & 31)] = gk ? v[i] * gk[k0 + kk] : v[i]; }
    LDS_WAIT(); asm volatile("" ::: "memory");
    const int c = lane & 7;
#pragma unroll
    for (int j = 0; j < 4; ++j) { const int n = (lane >> 3) + 8 * j; const LAS float* s = scr + (8 * c) * 33 + n;
        u32x4 o; o.x = cvt_pk_bf16(s[0 * 33], s[1 * 33]); o.y = cvt_pk_bf16(s[2 * 33], s[3 * 33]); o.z = cvt_pk_bf16(s[4 * 33], s[5 * 33]); o.w = cvt_pk_bf16(s[6 * 33], s[7 * 33]);
        *(u32x4*)(WT + (size_t)(n0 + n) * ldw + koff + k0 + 8 * c) = o; }
    LDS_WAIT(); asm volatile("" ::: "memory");
}

struct Args {
    const float* x; const int* pos;
    const float *g1, *w1g, *w1u, *w1d, *gmix, *win, *bi, *bf, *gno, *sinks, *wbm, *wba, *wo, *g2, *w2g, *w2u, *w2d, *gfin;
    float* out; unsigned char* ws; int ph_lo, ph_hi;
};

__device__ __forceinline__ void p0_prologue(const Args& a, LAS unsigned char* lds, int gw, int NGW, int wave, int lane) {
    unsigned char* ws = a.ws;
    LAS float* scr = (LAS float*)(lds + wave * 16384);
    constexpr int I_GU = (DM / 64) * (NGU / 32), I_D = (DFF / 64) * (DM / 32), I_IN = (DM / 64) * (NIN / 32), I_BR = (512 / 64) * (DM / 32), I_O = (DM / 64) * (DM / 32);
    constexpr int NITEMS = 2 * I_GU + 2 * I_D + I_IN + 2 * I_BR + I_O;
    for (int it = gw; it < NITEMS; it += NGW) {
        int r = it;
        if (r < 2 * I_GU) {
            const bool second = r >= I_GU; if (second) r -= I_GU;
            const int nblk = NGU / 32, kb = r / nblk, nb = r % nblk, n = nb * 32 + (lane & 31);
            const float* wg = second ? a.w2g : a.w1g; const float* wu = second ? a.w2u : a.w1u;
            const float* colp = (((n >> 7) & 1) ? wu : wg) + 128 * (n >> 8) + (n & 127);
            transpose_item(colp, DFF, second ? a.g2 : a.g1, (bf16_t*)(ws + (second ? WS_W2GU : WS_W1GU)), DM, 0, kb * 64, nb * 32, scr, lane);
            continue;
        }
        r -= 2 * I_GU;
        if (r < 2 * I_D) {
            const bool second = r >= I_D; if (second) r -= I_D;
            const int nblk = DM / 32, kb = r / nblk, nb = r % nblk, n = nb * 32 + (lane & 31);
            transpose_item((second ? a.w2d : a.w1d) + n, DM, nullptr, (bf16_t*)(ws + (second ? WS_W2D : WS_W1D)), DFF, 0, kb * 64, nb * 32, scr, lane);
            continue;
        }
        r -= 2 * I_D;
        if (r < I_IN) {
            const int nblk = NIN / 32, kb = r / nblk, nb = r % nblk, n = nb * 32 + (lane & 31);
            int src = -1;
            if (n < 1536) src = n; else if (n < 2304) src = n + 8;
            else if (n < 4352) { const int t = n - 2304; src = (((t >> 7) & 1) ? 3336 : 2312) + 128 * (t >> 8) + (t & 127); }
            else if (n < 4360) src = n - 4352 + 1536;
            transpose_item(src >= 0 ? a.win + src : nullptr, WIN_SRC, a.gmix, (bf16_t*)(ws + WS_WIN), DM, 0, kb * 64, nb * 32, scr, lane);
            continue;
        }
        r -= I_IN;
        if (r < 2 * I_BR) {
            const bool second = r >= I_BR; if (second) r -= I_BR;
            const int nblk = DM / 32, kb = r / nblk, nb = r % nblk, n = nb * 32 + (lane & 31);
            transpose_item((second ? a.wba : a.wbm) + n, DM, nullptr, (bf16_t*)(ws + WS_WBR), DM, second ? 512 : 0, kb * 64, nb * 32, scr, lane);
            continue;
        }
        r -= 2 * I_BR;
        { const int nblk = DM / 32, kb = r / nblk, nb = r % nblk, n = nb * 32 + (lane & 31);
          transpose_item(a.wo + n, DM, nullptr, (bf16_t*)(ws + WS_WO), DM, 0, kb * 64, nb * 32, scr, lane); }
    }
    float* ss0 = (float*)(ws + WS_SS);
    bf16_t* XB = (bf16_t*)(ws + WS_XB);
    for (int m0 = gw; m0 < M; m0 += 8 * NGW) {
        f32x4 v[8][4];
#pragma unroll
        for (int r = 0; r < 8; ++r) { const int m = m0 + r * NGW; const f32x4* xr = (const f32x4*)(a.x + (size_t)(m < M ? m : gw) * DM) + lane;
#pragma unroll
            for (int j = 0; j < 4; ++j) v[r][j] = xr[64 * j]; }
#pragma unroll
        for (int r = 0; r < 8; ++r) { const int m = m0 + r * NGW; if (m >= M) break;
            float s = 0.f;
#pragma unroll
            for (int j = 0; j < 4; ++j) s += (v[r][j].x * v[r][j].x + v[r][j].y * v[r][j].y) + (v[r][j].z * v[r][j].z + v[r][j].w * v[r][j].w);
            s = wave_sum(s);
            if (lane == 0) ss0[m] = s;
            u32x2* o8 = (u32x2*)(XB + (size_t)m * DM) + lane;
#pragma unroll
            for (int j = 0; j < 4; ++j) { u32x2 w; w.x = cvt_pk_bf16(v[r][j].x, v[r][j].y); w.y = cvt_pk_bf16(v[r][j].z, v[r][j].w); o8[64 * j] = w; } }
    }
    float* rope = (float*)(ws + WS_ROPE);
    for (int idx = gw * 64 + lane; idx < M * 8; idx += NGW * 64) {
        const int row = idx >> 3, i = idx & 7;
        const float inv = i == 0 ? 1.0f : i == 1 ? 0.1939227432012558f : i == 2 ? 0.03760603070259094f : i == 3 ? 0.007292664609849453f : i == 4 ? 0.0014142135623842478f
                        : i == 5 ? 0.00027424818836152554f : i == 6 ? 5.3182957344688475e-05f : 1.0313385246263351e-05f;
        const float ang = (float)a.pos[row] * inv; float sn, cs; sincosf(ang, &sn, &cs);
        rope[(size_t)row * 16 + i] = cs; rope[(size_t)row * 16 + 8 + i] = sn;
    }
}

#define MFMA16(a, b, c) __builtin_amdgcn_mfma_f32_16x16x32_bf16((a), (b), (c), 0, 0, 0)
constexpr int ML_QS = 0, ML_KS = 9216, ML_KWT = 18432, ML_VT = 27648, ML_SQK = 46080, ML_CB = 55296, ML_HB = 73728, ML_SC = 107520;
constexpr int ML_TB = 109056;
constexpr int LP = 72;
constexpr int HBP = 132;

constexpr int ML_GROUP = 8, ML_NG = (SEQ / 64) / ML_GROUP;
__device__ __forceinline__ float fast_tanh(float x) { return 1.f - 2.f * __builtin_amdgcn_rcpf(1.f + __expf(2.f * x)); }

template <bool STATE_ONLY>
__device__ __forceinline__ void mlstm_group(const Args& a, LAS unsigned char* lds, int bh, int grp, int tid, int wave, int lane) {
    const int b = bh >> 2, h = bh & 3;
    const bf16_t* P = (const bf16_t*)(a.ws + WS_ACT);
    const float* GT = (const float*)(a.ws + WS_GATES);
    bf16_t* HO = (bf16_t*)(a.ws + WS_HO);
    float* CG = (float*)(a.ws + WS_CG); float* NGs = (float*)(a.ws + WS_NG); float* SG = (float*)(a.ws + WS_SG); float* CHS = (float*)(a.ws + WS_CHS);
    LAS bf16_t* QS = (LAS bf16_t*)(lds + ML_QS); LAS bf16_t* KS = (LAS bf16_t*)(lds + ML_KS); LAS bf16_t* KWT = (LAS bf16_t*)(lds + ML_KWT);
    LAS bf16_t* VT = (LAS bf16_t*)(lds + ML_VT); LAS bf16_t* SQK = (LAS bf16_t*)(lds + ML_SQK); LAS bf16_t* CB = (LAS bf16_t*)(lds + ML_CB);
    LAS float* HB = (LAS float*)(lds + ML_HB); LAS float* SC = (LAS float*)(lds + ML_SC);
    LAS float* s_rowterm = SC, * s_dcol = SC + 64, * s_iscale = SC + 128, * s_emrow = SC + 192, * s_n = SC + 256;
    const int fr = lane & 15, fq = lane >> 4;
    const float b_i = a.bi[h], b_f = a.bf[h];
    const int c0 = grp * ML_GROUP;
    f32x4 cacc[4];
#pragma unroll
    for (int kt = 0; kt < 4; ++kt) cacc[kt] = (f32x4){0.f, 0.f, 0.f, 0.f};
    float m_prev, bsum = 0.f;
    if constexpr (STATE_ONLY) {
        m_prev = -1e30f;
        if (tid < 64) s_n[(c0 & 1) * 64 + tid] = 0.f;
    } else {
        float m = 0.f;
        for (int c = 0; c < c0; ++c) { const float bl_c = CHS[(bh * 32 + c) * 2], am_c = CHS[(bh * 32 + c) * 2 + 1]; m = fmaxf(bl_c + m, am_c); }
        m_prev = m;
        float nacc = 0.f;
        for (int gp = 0; gp < grp; ++gp) {
            float e = SG[(bh * 4 + gp) * 2] - m;
            for (int g2 = gp + 1; g2 < grp; ++g2) e += SG[(bh * 4 + g2) * 2 + 1];
            const float coef = __expf(e);
            const float* cg = CG + (size_t)(bh * 4 + gp) * 8192;
#pragma unroll
            for (int kt = 0; kt < 4; ++kt)
#pragma unroll
                for (int i = 0; i < 4; ++i) cacc[kt][i] += coef * cg[(16 * wave + 4 * fq + i) * 64 + 16 * kt + fr];
            if (tid < 64) nacc += coef * NGs[(bh * 4 + gp) * 64 + tid];
        }
        if (tid < 64) s_n[(c0 & 1) * 64 + tid] = nacc;
#pragma unroll
        for (int kt = 0; kt < 4; ++kt)
#pragma unroll
            for (int i = 0; i < 4; ++i) CB[(16 * wave + 4 * fq + i) * LP + 16 * kt + fr] = f2bf(cacc[kt][i]);
    }
    const int l_qk = tid >> 3, pc_qk = tid & 7;
    const int j_n = tid >> 3, seg_n = tid & 7;
    const size_t rowbase = (size_t)b * SEQ;
    const int lp = tid & 31, pcg = tid >> 5;
    constexpr int PD = STATE_ONLY ? ML_GROUP : 2;
    u32x4 rq[PD], rk[PD], rv[PD][2], ro[PD][2]; u32x2 rk2[PD][2];
#define ML_LOAD(c, S) do { const size_t r0_ = rowbase + (size_t)(c) * 64; \
        if constexpr (!STATE_ONLY) { rk[S] = *(const u32x4*)(P + (r0_ + l_qk) * NIN + PC_KM + h * 64 + pc_qk * 8); rq[S] = *(const u32x4*)(P + (r0_ + l_qk) * NIN + PC_QM + h * 64 + pc_qk * 8); } \
        _Pragma("unroll") for (int i_ = 0; i_ < 2; ++i_) { rv[S][i_] = *(const u32x4*)(P + (r0_ + 2 * lp + i_) * NIN + PC_VM + h * 128 + pcg * 8); \
            rk2[S][i_] = *(const u32x2*)(P + (r0_ + 2 * lp + i_) * NIN + PC_KM + h * 64 + pcg * 4); \
            if constexpr (!STATE_ONLY) ro[S][i_] = *(const u32x4*)(P + (r0_ + j_n) * NIN + PC_OM + h * 128 + seg_n * 16 + i_ * 8); } } while (0)
#pragma unroll
    for (int d = 0; d < PD; ++d) ML_LOAD(c0 + d, d);
    LAS float* T_av = (LAS float*)(lds + ML_TB); LAS float* T_dcol = T_av + 512; LAS float* T_pmx = T_dcol + 512; LAS float* T_bc = T_pmx + 512; LAS float* T_sc = T_bc + 512;
    {
        const size_t r = rowbase + (size_t)(c0 + wave) * 64 + lane;
        const float gi = GT[r * 8 + h], gf = GT[r * 8 + 4 + h];
        const float ipre = 15.f * fast_tanh((gi + b_i) * (1.f / 15.f)), fpre = 15.f * fast_tanh((gf + b_f) * (1.f / 15.f));
        float bc = -__logf(1.f + __expf(-fpre));
#pragma unroll
        for (int o = 1; o < 64; o <<= 1) { const float t = __shfl_up(bc, o); if (lane >= o) bc += t; }
        const float bl = __shfl(bc, 63);
        const float av = bl - bc + ipre;
        float amax = av;
#pragma unroll
        for (int o = 1; o < 64; o <<= 1) amax = fmaxf(amax, __shfl_xor(amax, o));
        const float dcol = ipre - bc;
        float pmx = dcol;
#pragma unroll
        for (int o = 1; o < 64; o <<= 1) { const float t = __shfl_up(pmx, o); if (lane >= o) pmx = fmaxf(pmx, t); }
        T_av[wave * 64 + lane] = av; T_dcol[wave * 64 + lane] = dcol; T_pmx[wave * 64 + lane] = pmx; T_bc[wave * 64 + lane] = bc;
        if (lane == 0) { T_sc[wave] = bl; T_sc[8 + wave] = amax;
            if constexpr (STATE_ONLY) { CHS[(bh * 32 + c0 + wave) * 2] = bl; CHS[(bh * 32 + c0 + wave) * 2 + 1] = amax; } }
    }
    __syncthreads();
#pragma unroll PD
    for (int ci = 0; ci < ML_GROUP; ++ci) {
        const int c = c0 + ci, si = ci % PD;
        LAS float* n_cur = s_n + (c & 1) * 64; LAS float* n_nxt = s_n + ((c + 1) & 1) * 64;
        const float bl = T_sc[ci], amax = T_sc[8 + ci];
        const float m_new = fmaxf(bl + m_prev, amax);
        const float decay = __expf(bl + m_prev - m_new);
        if constexpr (STATE_ONLY) bsum += bl;
        if constexpr (!STATE_ONLY) {
            if (wave == 0) { const float pmx = T_pmx[ci * 64 + lane], bc = T_bc[ci * 64 + lane], mx = fmaxf(m_prev, pmx);
                s_rowterm[lane] = -mx; s_dcol[lane] = T_dcol[ci * 64 + lane]; s_iscale[lane] = __expf(m_prev - mx); s_emrow[lane] = __expf(-(bc + mx)); }
        }
        {
            if constexpr (!STATE_ONLY) {
                u32x4 q2;
                const u32x4 rqs = rq[si];
                q2.x = cvt_pk_bf16(bflo(rqs.x) * 0.125f, bfhi(rqs.x) * 0.125f); q2.y = cvt_pk_bf16(bflo(rqs.y) * 0.125f, bfhi(rqs.y) * 0.125f);
                q2.z = cvt_pk_bf16(bflo(rqs.z) * 0.125f, bfhi(rqs.z) * 0.125f); q2.w = cvt_pk_bf16(bflo(rqs.w) * 0.125f, bfhi(rqs.w) * 0.125f);
                *(LAS u32x4*)(QS + l_qk * LP + pc_qk * 8) = q2;
                *(LAS u32x4*)(KS + l_qk * LP + pc_qk * 8) = rk[si];
            }
            const f32x2 av2 = *(const LAS f32x2*)(T_av + ci * 64 + 2 * lp);
            const float wA = __expf(av2.x - m_new), wB = __expf(av2.y - m_new);
            LAS unsigned* KWT32 = (LAS unsigned*)KWT; LAS unsigned* VT32 = (LAS unsigned*)VT;
#pragma unroll
            for (int q = 0; q < 2; ++q) { const unsigned ka = rk2[si][0][q], kb = rk2[si][1][q];
                KWT32[(pcg * 4 + 2 * q) * (LP / 2) + lp] = cvt_pk_bf16(bflo(ka) * wA, bflo(kb) * wB); KWT32[(pcg * 4 + 2 * q + 1) * (LP / 2) + lp] = cvt_pk_bf16(bfhi(ka) * wA, bfhi(kb) * wB); }
#pragma unroll
            for (int q = 0; q < 4; ++q) { const unsigned va = rv[si][0][q], vb = rv[si][1][q];
                VT32[(pcg * 8 + 2 * q) * (LP / 2) + lp] = (va & 0xffffu) | (vb << 16); VT32[(pcg * 8 + 2 * q + 1) * (LP / 2) + lp] = (va >> 16) | (vb & 0xffff0000u); }
        }
        u32x4 og0, og1;
        if constexpr (!STATE_ONLY) { og0 = ro[si][0]; og1 = ro[si][1]; }
        if (ci + PD < ML_GROUP) ML_LOAD(c + PD, si);
        __syncthreads();
        {
            if constexpr (!STATE_ONLY) {
                const int jt = wave >> 1, j = 16 * jt + fr;
                const bf16x8 bq0 = *(const LAS bf16x8*)(QS + j * LP + 8 * fq), bq1 = *(const LAS bf16x8*)(QS + j * LP + 32 + 8 * fq);
                const float rtm = s_rowterm[j], isc = s_iscale[j], emr = s_emrow[j];
                f32x4 sq[4]; float dsum = 0.f;
#pragma unroll
                for (int ct = 0; ct < 4; ++ct) {
                    const bf16x8 k0 = *(const LAS bf16x8*)(KS + (16 * ct + fr) * LP + 8 * fq), k1 = *(const LAS bf16x8*)(KS + (16 * ct + fr) * LP + 32 + 8 * fq);
                    f32x4 v = (f32x4){0.f, 0.f, 0.f, 0.f};
                    v = MFMA16(k0, bq0, v); v = MFMA16(k1, bq1, v);
                    const f32x4 dc = *(const LAS f32x4*)(s_dcol + 16 * ct + 4 * fq);
#pragma unroll
                    for (int i = 0; i < 4; ++i) { const float p = (16 * ct + 4 * fq + i <= j) ? v[i] * __expf(rtm + dc[i]) : 0.f; v[i] = p; dsum += p; }
                    sq[ct] = v;
                }
                float qn = 0.f;
                {
                    const f32x4 n0 = *(const LAS f32x4*)(n_cur + 8 * fq), n1 = *(const LAS f32x4*)(n_cur + 8 * fq + 4), n2 = *(const LAS f32x4*)(n_cur + 32 + 8 * fq), n3 = *(const LAS f32x4*)(n_cur + 32 + 8 * fq + 4);
                    const u32x4 q0 = __builtin_bit_cast(u32x4, bq0), q1 = __builtin_bit_cast(u32x4, bq1);
                    qn += bflo(q0[0]) * n0[0] + bfhi(q0[0]) * n0[1] + bflo(q0[1]) * n0[2] + bfhi(q0[1]) * n0[3];
                    qn += bflo(q0[2]) * n1[0] + bfhi(q0[2]) * n1[1] + bflo(q0[3]) * n1[2] + bfhi(q0[3]) * n1[3];
                    qn += bflo(q1[0]) * n2[0] + bfhi(q1[0]) * n2[1] + bflo(q1[1]) * n2[2] + bfhi(q1[1]) * n2[3];
                    qn += bflo(q1[2]) * n3[0] + bfhi(q1[2]) * n3[1] + bflo(q1[3]) * n3[2] + bfhi(q1[3]) * n3[3];
                }
                float den = dsum + isc * qn;
                den += __shfl_xor(den, 16); den += __shfl_xor(den, 32);
                const float dnm = __builtin_amdgcn_rcpf(fmaxf(fabsf(den), emr));
                bf16x8 pf[2];
#pragma unroll
                for (int ks = 0; ks < 2; ++ks) { u32x4 w; w.x = cvt_pk_bf16(sq[2 * ks][0], sq[2 * ks][1]); w.y = cvt_pk_bf16(sq[2 * ks][2], sq[2 * ks][3]);
                    w.z = cvt_pk_bf16(sq[2 * ks + 1][0], sq[2 * ks + 1][1]); w.w = cvt_pk_bf16(sq[2 * ks + 1][2], sq[2 * ks + 1][3]); pf[ks] = __builtin_bit_cast(bf16x8, w); }
#pragma unroll
                for (int tt = 0; tt < 4; ++tt) {
                    const int et = 4 * (wave & 1) + tt;
                    const LAS bf16_t* vp = VT + (16 * et + fr) * LP + 4 * fq;
                    f32x4 xa = (f32x4){0.f, 0.f, 0.f, 0.f}, xb = (f32x4){0.f, 0.f, 0.f, 0.f};
#pragma unroll
                    for (int ks = 0; ks < 2; ++ks) { const u32x2 lo = *(const LAS u32x2*)(vp + 32 * ks), hi2 = *(const LAS u32x2*)(vp + 32 * ks + 16);
                        xa = MFMA16(__builtin_bit_cast(bf16x8, ((u32x4){lo.x, lo.y, hi2.x, hi2.y})), pf[ks], xa); }
                    const bf16x8 cb0 = *(const LAS bf16x8*)(CB + (16 * et + fr) * LP + 8 * fq), cb1 = *(const LAS bf16x8*)(CB + (16 * et + fr) * LP + 32 + 8 * fq);
                    xb = MFMA16(cb0, bq0, xb); xb = MFMA16(cb1, bq1, xb);
                    *(LAS f32x4*)(HB + j * HBP + 16 * et + 4 * fq) = (xa + xb * isc) * dnm;
                }
            }
            const bf16x8 va0 = *(const LAS bf16x8*)(VT + (16 * wave + fr) * LP + 8 * fq), va1 = *(const LAS bf16x8*)(VT + (16 * wave + fr) * LP + 32 + 8 * fq);
#pragma unroll
            for (int kt = 0; kt < 4; ++kt) {
                const bf16x8 kb0 = *(const LAS bf16x8*)(KWT + (16 * kt + fr) * LP + 8 * fq), kb1 = *(const LAS bf16x8*)(KWT + (16 * kt + fr) * LP + 32 + 8 * fq);
                f32x4 t = cacc[kt] * decay;
                t = MFMA16(va0, kb0, t); t = MFMA16(va1, kb1, t);
                cacc[kt] = t;
            }
            {
                const u32x4 kv = *(const LAS u32x4*)(KWT + j_n * LP + seg_n * 8);
                float sn = (bflo(kv[0]) + bfhi(kv[0])) + (bflo(kv[1]) + bfhi(kv[1])) + (bflo(kv[2]) + bfhi(kv[2])) + (bflo(kv[3]) + bfhi(kv[3]));
                sn += __shfl_xor(sn, 1); sn += __shfl_xor(sn, 2); sn += __shfl_xor(sn, 4);
                if (seg_n == 0) n_nxt[j_n] = decay * n_cur[j_n] + sn;
            }
        }
        __syncthreads();
        if constexpr (!STATE_ONLY) {
#pragma unroll
            for (int kt = 0; kt < 4; ++kt)
#pragma unroll
                for (int i = 0; i < 4; ++i) CB[(16 * wave + 4 * fq + i) * LP + 16 * kt + fr] = f2bf(cacc[kt][i]);
            float hv[16]; float sq = 0.f;
#pragma unroll
            for (int q = 0; q < 4; ++q) { const f32x4 t = *(const LAS f32x4*)(HB + j_n * HBP + seg_n * 16 + 4 * q); hv[4 * q] = t[0]; hv[4 * q + 1] = t[1]; hv[4 * q + 2] = t[2]; hv[4 * q + 3] = t[3];
                sq += (t[0] * t[0] + t[1] * t[1]) + (t[2] * t[2] + t[3] * t[3]); }
            sq += __shfl_xor(sq, 1); sq += __shfl_xor(sq, 2); sq += __shfl_xor(sq, 4);
            const float rn = rsqrtf(sq * (1.0f / 128.f) + NORM_EPS);
            const float* gp = a.gno + h * 128 + seg_n * 16;
            float ov[16];
#pragma unroll
            for (int q = 0; q < 4; ++q) { ov[2 * q] = bflo(og0[q]); ov[2 * q + 1] = bfhi(og0[q]); ov[8 + 2 * q] = bflo(og1[q]); ov[8 + 2 * q + 1] = bfhi(og1[q]); }
            unsigned pk[8];
#pragma unroll
            for (int q = 0; q < 8; ++q) { const float v0 = hv[2 * q] * rn * gp[2 * q] * sigm(ov[2 * q]), v1 = hv[2 * q + 1] * rn * gp[2 * q + 1] * sigm(ov[2 * q + 1]); pk[q] = cvt_pk_bf16(v0, v1); }
            bf16_t* dst = HO + (rowbase + (size_t)c * 64 + j_n) * DM + h * 128 + seg_n * 16;
            *(u32x4*)dst = (u32x4){pk[0], pk[1], pk[2], pk[3]}; *(u32x4*)(dst + 8) = (u32x4){pk[4], pk[5], pk[6], pk[7]};
        }
        m_prev = m_new;
    }
    if constexpr (STATE_ONLY) {
        float* cg = CG + (size_t)(bh * 4 + grp) * 8192;
#pragma unroll
        for (int kt = 0; kt < 4; ++kt)
#pragma unroll
            for (int i = 0; i < 4; ++i) cg[(16 * wave + 4 * fq + i) * 64 + 16 * kt + fr] = cacc[kt][i];
        if (tid < 64) NGs[(bh * 4 + grp) * 64 + tid] = s_n[((c0 + ML_GROUP) & 1) * 64 + tid];
        if (tid == 0) { SG[(bh * 4 + grp) * 2] = m_prev; SG[(bh * 4 + grp) * 2 + 1] = bsum; }
    }
    __syncthreads();
#undef ML_LOAD
}

constexpr int ML2_VT = 0, ML2_KWT = 67584, LP2 = 264;
__device__ __forceinline__ void mlstm_state_group(const Args& a, LAS unsigned char* lds, int bh, int grp, int tid, int wave, int lane) {
    const int b = bh >> 2, h = bh & 3;
    const bf16_t* P = (const bf16_t*)(a.ws + WS_ACT);
    const float* GT = (const float*)(a.ws + WS_GATES);
    float* CG = (float*)(a.ws + WS_CG); float* NGs = (float*)(a.ws + WS_NG); float* SG = (float*)(a.ws + WS_SG); float* CHS = (float*)(a.ws + WS_CHS);
    LAS bf16_t* VT = (LAS bf16_t*)(lds + ML2_VT); LAS bf16_t* KWT = (LAS bf16_t*)(lds + ML2_KWT);
    LAS float* T_av = (LAS float*)(lds + ML_TB); LAS float* T_sc = T_av + 2048;
    const int fr = lane & 15, fq = lane >> 4;
    const float b_i = a.bi[h], b_f = a.bf[h];
    const int c0 = grp * ML_GROUP;
    const size_t rowbase = (size_t)b * SEQ;
    const int lp = tid & 31, pcg = tid >> 5;
    u32x4 rv[ML_GROUP][2]; u32x2 rk2[ML_GROUP][2];
#pragma unroll
    for (int ci = 0; ci < ML_GROUP; ++ci) { const size_t r0 = rowbase + (size_t)(c0 + ci) * 64;
#pragma unroll
        for (int i = 0; i < 2; ++i) { rv[ci][i] = *(const u32x4*)(P + (r0 + 2 * lp + i) * NIN + PC_VM + h * 128 + pcg * 8); rk2[ci][i] = *(const u32x2*)(P + (r0 + 2 * lp + i) * NIN + PC_KM + h * 64 + pcg * 4); } }
    {
        const size_t r = rowbase + (size_t)(c0 + wave) * 64 + lane;
        const float gi = GT[r * 8 + h], gf = GT[r * 8 + 4 + h];
        const float ipre = 15.f * fast_tanh((gi + b_i) * (1.f / 15.f)), fpre = 15.f * fast_tanh((gf + b_f) * (1.f / 15.f));
        float bc = -__logf(1.f + __expf(-fpre));
#pragma unroll
        for (int o = 1; o < 64; o <<= 1) { const float t = __shfl_up(bc, o); if (lane >= o) bc += t; }
        const float bl = __shfl(bc, 63);
        const float av = bl - bc + ipre;
        float amax = av;
#pragma unroll
        for (int o = 1; o < 64; o <<= 1) amax = fmaxf(amax, __shfl_xor(amax, o));
        T_av[wave * 64 + lane] = av;
        if (lane == 0) { T_sc[wave] = bl; T_sc[8 + wave] = amax; CHS[(bh * 32 + c0 + wave) * 2] = bl; CHS[(bh * 32 + c0 + wave) * 2 + 1] = amax; }
    }
    __syncthreads();
    float m_g = -1e30f, bsum = 0.f, sufB[ML_GROUP];
#pragma unroll
    for (int ci = 0; ci < ML_GROUP; ++ci) { m_g = fmaxf(T_sc[ci] + m_g, T_sc[8 + ci]); bsum += T_sc[ci]; }
    { float acc = 0.f;
#pragma unroll
      for (int ci = ML_GROUP - 1; ci >= 0; --ci) { sufB[ci] = acc; acc += T_sc[ci]; } }
    f32x4 cacc[4];
#pragma unroll
    for (int kt = 0; kt < 4; ++kt) cacc[kt] = (f32x4){0.f, 0.f, 0.f, 0.f};
    float nacc = 0.f;
    LAS unsigned* KWT32 = (LAS unsigned*)KWT; LAS unsigned* VT32 = (LAS unsigned*)VT;
#pragma unroll
    for (int hf = 0; hf < 2; ++hf) {
#pragma unroll
        for (int cc = 0; cc < 4; ++cc) {
            const int ci = 4 * hf + cc;
            const f32x2 av2 = *(const LAS f32x2*)(T_av + ci * 64 + 2 * lp);
            const float wA = __expf(av2.x + sufB[ci] - m_g), wB = __expf(av2.y + sufB[ci] - m_g);
#pragma unroll
            for (int q = 0; q < 2; ++q) { const unsigned ka = rk2[ci][0][q], kb = rk2[ci][1][q];
                KWT32[(pcg * 4 + 2 * q) * (LP2 / 2) + 32 * cc + lp] = cvt_pk_bf16(bflo(ka) * wA, bflo(kb) * wB); KWT32[(pcg * 4 + 2 * q + 1) * (LP2 / 2) + 32 * cc + lp] = cvt_pk_bf16(bfhi(ka) * wA, bfhi(kb) * wB); }
#pragma unroll
            for (int q = 0; q < 4; ++q) { const unsigned va = rv[ci][0][q], vb = rv[ci][1][q];
                VT32[(pcg * 8 + 2 * q) * (LP2 / 2) + 32 * cc + lp] = (va & 0xffffu) | (vb << 16); VT32[(pcg * 8 + 2 * q + 1) * (LP2 / 2) + 32 * cc + lp] = (va >> 16) | (vb & 0xffff0000u); }
        }
        __syncthreads();
#pragma unroll
        for (int ks = 0; ks < 8; ++ks) {
            const bf16x8 va = *(const LAS bf16x8*)(VT + (16 * wave + fr) * LP2 + 32 * ks + 8 * fq);
#pragma unroll
            for (int kt = 0; kt < 4; ++kt) { const bf16x8 kb = *(const LAS bf16x8*)(KWT + (16 * kt + fr) * LP2 + 32 * ks + 8 * fq); cacc[kt] = MFMA16(va, kb, cacc[kt]); }
        }
        {
            const int k = tid >> 3, seg = tid & 7; float sn = 0.f;
#pragma unroll
            for (int q4 = 0; q4 < 4; ++q4) { const u32x4 kv = *(const LAS u32x4*)(KWT + k * LP2 + seg * 32 + q4 * 8);
                sn += (bflo(kv[0]) + bfhi(kv[0])) + (bflo(kv[1]) + bfhi(kv[1])) + (bflo(kv[2]) + bfhi(kv[2])) + (bflo(kv[3]) + bfhi(kv[3])); }
            sn += __shfl_xor(sn, 1); sn += __shfl_xor(sn, 2); sn += __shfl_xor(sn, 4);
            nacc += sn;
        }
        __syncthreads();
    }
    float* cg = CG + (size_t)(bh * 4 + grp) * 8192;
#pragma unroll
    for (int kt = 0; kt < 4; ++kt)
#pragma unroll
        for (int i = 0; i < 4; ++i) cg[(16 * wave + 4 * fq + i) * 64 + 16 * kt + fr] = cacc[kt][i];
    if ((tid & 7) == 0) NGs[(bh * 4 + grp) * 64 + (tid >> 3)] = nacc;
    if (tid == 0) { SG[(bh * 4 + grp) * 2] = m_g; SG[(bh * 4 + grp) * 2 + 1] = bsum; }
}

constexpr int AT_KS = 0, AT_VT = 27648, AT_QS = 53248, AT_PS = 90112;
constexpr int VP = 200;

__device__ __forceinline__ void rope16(float (&x)[16], const float* tab) {
    const f32x4 c0 = *(const f32x4*)tab, c1 = *(const f32x4*)(tab + 4), s0 = *(const f32x4*)(tab + 8), s1 = *(const f32x4*)(tab + 12);
#pragma unroll
    for (int i = 0; i < 8; ++i) { const float cs = i < 4 ? c0[i & 3] : c1[i & 3], sn = i < 4 ? s0[i & 3] : s1[i & 3]; const float x1 = x[i], x2 = x[i + 8]; x[i] = x1 * cs - x2 * sn; x[i + 8] = x2 * cs + x1 * sn; }
}

__device__ __forceinline__ void attn_item(const Args& a, LAS unsigned char* lds, int item, int tid, int wave, int lane) {
    const int qb = item & 31, kvh = (item >> 5) & 1, b = item >> 6;
    const int q0 = qb * 64;
    const bf16_t* P = (const bf16_t*)(a.ws + WS_ACT);
    const float* rope = (const float*)(a.ws + WS_ROPE);
    bf16_t* HO = (bf16_t*)(a.ws + WS_HO);
    LAS bf16_t* KS = (LAS bf16_t*)(lds + AT_KS); LAS bf16_t* VT = (LAS bf16_t*)(lds + AT_VT); LAS bf16_t* QS = (LAS bf16_t*)(lds + AT_QS);
    LAS bf16_t* PS = (LAS bf16_t*)(lds + AT_PS) + wave * 16 * VP;
    const int fr = lane & 15, fq = lane >> 4;
    const size_t rowbase = (size_t)b * SEQ;
    const int grp = tid & 3;
    u32x4 kk[2][2], vv[2][2], qq[2][2]; f32x4 tk[2][4], tq[2][4];
#pragma unroll
    for (int it = 0; it < 2; ++it) {
        const int t = tid + 512 * it;
        const int kc = (t >> 2) < 192 ? (t >> 2) : 191, kpos = q0 - 128 + kc, kposc = kpos < 0 ? 0 : kpos;
        const bf16_t* kp = P + (rowbase + kposc) * NIN + PC_KA + kvh * 64 + grp * 16; kk[it][0] = *(const u32x4*)kp; kk[it][1] = *(const u32x4*)(kp + 8);
        const bf16_t* vp = P + (rowbase + kposc) * NIN + PC_VA + kvh * 64 + grp * 16; vv[it][0] = *(const u32x4*)vp; vv[it][1] = *(const u32x4*)(vp + 8);
        const float* tkp = rope + (rowbase + kposc) * 16;
#pragma unroll
        for (int q = 0; q < 4; ++q) tk[it][q] = *(const f32x4*)(tkp + 4 * q);
        const int qi = (t >> 2) & 63, gq = t >> 8;
        const size_t row = rowbase + q0 + qi;
        const bf16_t* qp = P + row * NIN + PC_QA + (kvh * 4 + gq) * 64 + grp * 16; qq[it][0] = *(const u32x4*)qp; qq[it][1] = *(const u32x4*)(qp + 8);
        const float* tqp = rope + row * 16;
#pragma unroll
        for (int q = 0; q < 4; ++q) tq[it][q] = *(const f32x4*)(tqp + 4 * q);
    }
#pragma unroll
    for (int it = 0; it < 2; ++it) {
        const int t = tid + 512 * it;
        {
            const int kc = t >> 2, kpos = q0 - 128 + kc;
            const bool live = (t < 768), ok = kpos >= 0;
            u32x4 k0 = kk[it][0], k1 = kk[it][1], v0 = vv[it][0], v1 = vv[it][1];
            if (grp == 0) {
                float x[16];
#pragma unroll
                for (int q = 0; q < 4; ++q) { x[2 * q] = bflo(k0[q]); x[2 * q + 1] = bfhi(k0[q]); x[8 + 2 * q] = bflo(k1[q]); x[8 + 2 * q + 1] = bfhi(k1[q]); }
#pragma unroll
                for (int i = 0; i < 8; ++i) { const float cs = tk[it][i >> 2][i & 3], sn = tk[it][2 + (i >> 2)][i & 3]; const float x1 = x[i], x2 = x[i + 8]; x[i] = x1 * cs - x2 * sn; x[i + 8] = x2 * cs + x1 * sn; }
#pragma unroll
                for (int q = 0; q < 4; ++q) { k0[q] = cvt_pk_bf16(x[2 * q], x[2 * q + 1]); k1[q] = cvt_pk_bf16(x[8 + 2 * q], x[8 + 2 * q + 1]); }
            }
            if (!ok) { k0 = (u32x4){0u, 0u, 0u, 0u}; k1 = k0; v0 = k0; v1 = k0; }
            if (live) {
                *(LAS u32x4*)(KS + kc * LP + grp * 16) = k0; *(LAS u32x4*)(KS + kc * LP + grp * 16 + 8) = k1;
#pragma unroll
                for (int q = 0; q < 4; ++q) { VT[(grp * 16 + 2 * q) * VP + kc] = (bf16_t)(v0[q] & 0xffffu); VT[(grp * 16 + 2 * q + 1) * VP + kc] = (bf16_t)(v0[q] >> 16);
                    VT[(grp * 16 + 8 + 2 * q) * VP + kc] = (bf16_t)(v1[q] & 0xffffu); VT[(grp * 16 + 8 + 2 * q + 1) * VP + kc] = (bf16_t)(v1[q] >> 16); }
            }
        }
        {
            const int qi = (t >> 2) & 63, gq = t >> 8;
            const u32x4 r0 = qq[it][0], r1 = qq[it][1];
            float x[16];
#pragma unroll
            for (int q = 0; q < 4; ++q) { x[2 * q] = bflo(r0[q]); x[2 * q + 1] = bfhi(r0[q]); x[8 + 2 * q] = bflo(r1[q]); x[8 + 2 * q + 1] = bfhi(r1[q]); }
            if (grp == 0) {
#pragma unroll
                for (int i = 0; i < 8; ++i) { const float cs = tq[it][i >> 2][i & 3], sn = tq[it][2 + (i >> 2)][i & 3]; const float x1 = x[i], x2 = x[i + 8]; x[i] = x1 * cs - x2 * sn; x[i + 8] = x2 * cs + x1 * sn; }
            }
            u32x4 o0, o1;
#pragma unroll
            for (int q = 0; q < 4; ++q) { o0[q] = cvt_pk_bf16(x[2 * q] * 0.125f, x[2 * q + 1] * 0.125f); o1[q] = cvt_pk_bf16(x[8 + 2 * q] * 0.125f, x[8 + 2 * q + 1] * 0.125f); }
            *(LAS u32x4*)(QS + (gq * 64 + qi) * LP + grp * 16) = o0; *(LAS u32x4*)(QS + (gq * 64 + qi) * LP + grp * 16 + 8) = o1;
        }
    }
    __syncthreads();
    const int g = wave >> 1;
    const float sink = a.sinks[kvh * 4 + g];
    constexpr float LOG2E = 1.4426950408889634f;
#pragma unroll 1
    for (int rr = 0; rr < 2; ++rr) {
        const int rt = 2 * (wave & 1) + rr;
        const bf16x8 bq0 = *(const LAS bf16x8*)(QS + (g * 64 + 16 * rt + fr) * LP + 8 * fq), bq1 = *(const LAS bf16x8*)(QS + (g * 64 + 16 * rt + fr) * LP + 32 + 8 * fq);
        f32x4 s[9];
#pragma unroll
        for (int t = 0; t < 9; ++t) {
            const LAS bf16_t* kp = KS + (16 * (rt + t) + fr) * LP + 8 * fq;
            const bf16x8 k0 = *(const LAS bf16x8*)kp, k1 = *(const LAS bf16x8*)(kp + 32);
            f32x4 v = (f32x4){0.f, 0.f, 0.f, 0.f};
            v = MFMA16(k0, bq0, v); v = MFMA16(k1, bq1, v); s[t] = v;
        }
#pragma unroll
        for (int i = 0; i < 4; ++i) { if (!(4 * fq + i > fr)) s[0][i] = -INFINITY; if (!(4 * fq + i <= fr)) s[8][i] = -INFINITY; }
        if (q0 < 128) {
#pragma unroll
            for (int t = 0; t < 9; ++t)
#pragma unroll
                for (int i = 0; i < 4; ++i) { if (q0 - 128 + 16 * (rt + t) + 4 * fq + i < 0) s[t][i] = -INFINITY; }
        }
        float mx = sink;
#pragma unroll
        for (int t = 0; t < 9; ++t) mx = fmaxf(mx, fmaxf(fmaxf(s[t][0], s[t][1]), fmaxf(s[t][2], s[t][3])));
        mx = fmaxf(mx, __shfl_xor(mx, 16)); mx = fmaxf(mx, __shfl_xor(mx, 32));
        const float nmx2 = -mx * LOG2E;
        float sum = 0.f;
#pragma unroll
        for (int t = 0; t < 9; ++t)
#pragma unroll
            for (int i = 0; i < 4; ++i) { const float p = __builtin_amdgcn_exp2f(__builtin_fmaf(s[t][i], LOG2E, nmx2)); s[t][i] = p; sum += p; }
        sum += __shfl_xor(sum, 16); sum += __shfl_xor(sum, 32);
        const float inv = __builtin_amdgcn_rcpf(sum + __builtin_amdgcn_exp2f(__builtin_fmaf(sink, LOG2E, nmx2)));
        bf16x8 pf[5];
#pragma unroll
        for (int ks = 0; ks < 5; ++ks) {
            u32x4 w; w.x = cvt_pk_bf16(s[2 * ks][0], s[2 * ks][1]); w.y = cvt_pk_bf16(s[2 * ks][2], s[2 * ks][3]);
            if (ks < 4) { w.z = cvt_pk_bf16(s[2 * ks + 1][0], s[2 * ks + 1][1]); w.w = cvt_pk_bf16(s[2 * ks + 1][2], s[2 * ks + 1][3]); } else { w.z = 0u; w.w = 0u; }
            pf[ks] = __builtin_bit_cast(bf16x8, w);
        }
        f32x4 o[4];
#pragma unroll
        for (int dt = 0; dt < 4; ++dt) {
            f32x4 acc = (f32x4){0.f, 0.f, 0.f, 0.f};
            const LAS bf16_t* vp = VT + (16 * dt + fr) * VP + 16 * rt + 4 * fq;
#pragma unroll
            for (int ks = 0; ks < 5; ++ks) {
                u32x4 w; const u32x2 lo = *(const LAS u32x2*)(vp + 32 * ks); w.x = lo.x; w.y = lo.y;
                if (ks < 4) { const u32x2 hi2 = *(const LAS u32x2*)(vp + 32 * ks + 16); w.z = hi2.x; w.w = hi2.y; } else { w.z = 0u; w.w = 0u; }
                acc = MFMA16(__builtin_bit_cast(bf16x8, w), pf[ks], acc);
            }
            o[dt] = acc;
        }
        bf16_t* op = HO + (rowbase + q0 + 16 * rt + fr) * DM + 512 + (kvh * 4 + g) * 64 + 4 * fq;
#pragma unroll
        for (int dt = 0; dt < 4; ++dt) { u32x2 w; w.x = cvt_pk_bf16(o[dt][0] * inv, o[dt][1] * inv); w.y = cvt_pk_bf16(o[dt][2] * inv, o[dt][3] * inv); *(u32x2*)(op + 16 * dt) = w; }
    }
    __syncthreads();
}

#define XB_TMO      128
#define XB_XCNT(j)  (256  + 64 * (j))
#define XB_XSUB(j)  (1280 + 64 * (j))
#define XB_XGEN(j)  (2304 + 64 * (j))
#define XB_TOP      3328
#define XB_TOPGEN   3392
#define XCD_BAR_WORDS 3456
#define XB_SPIN_CAP (1u << 18)
__device__ __forceinline__ unsigned xb_ld(unsigned* p)              { return __hip_atomic_load(p, __ATOMIC_RELAXED, __HIP_MEMORY_SCOPE_AGENT); }
__device__ __forceinline__ unsigned xb_add(unsigned* p, unsigned v) { return __hip_atomic_fetch_add(p, v, __ATOMIC_RELAXED, __HIP_MEMORY_SCOPE_AGENT); }
__device__ __forceinline__ unsigned xb_xcc_id() { return (unsigned)__builtin_amdgcn_s_getreg((3 << 11) | 20) & 0xFu; }
#define XB_SPIN(cond, bar) do { unsigned _sp = 0; while (cond) { __builtin_amdgcn_s_sleep(1); \
    if ((++_sp & 255u) == 0u) { if (xb_ld(&(bar)[XB_TMO])) break; if (_sp > XB_SPIN_CAP) { atomicAdd(&(bar)[XB_TMO], 1u); break; } } } } while (0)
struct XcdBarrier { unsigned* bar; unsigned x; volatile LAS unsigned* st; };
__device__ __forceinline__ XcdBarrier xcd_barrier_post(unsigned* bar, volatile LAS unsigned* st) {
    XcdBarrier b; b.bar = bar; b.x = xb_xcc_id(); b.st = st;
    if (threadIdx.x == 0) (void)xb_add(&bar[XB_XCNT(b.x)], 1u);
    return b;
}
__device__ __forceinline__ void xcd_barrier_complete(unsigned* bar, unsigned x, unsigned& nloc, unsigned& nx) {
    const unsigned G = gridDim.x * gridDim.y * gridDim.z;
    unsigned sum, cnt, mine, sp = 0u;
    for (;;) {
        sum = 0u; cnt = 0u; mine = 0u;
#pragma unroll
        for (unsigned j = 0; j < 16; ++j) { const unsigned c = xb_ld(&bar[XB_XCNT(j)]); sum += c; cnt += (c > 0u) ? 1u : 0u; mine = (j == x) ? c : mine; }
        if (sum == G) break;
        __builtin_amdgcn_s_sleep(1);
        if ((++sp & 255u) == 0u) { if (xb_ld(&bar[XB_TMO])) break; if (sp > XB_SPIN_CAP) { atomicAdd(&bar[XB_TMO], 1u); break; } }
    }
    nloc = mine > 0u ? mine : 1u; nx = cnt > 0u ? cnt : 1u;
}
__device__ __forceinline__ void xcd_barrier(const XcdBarrier& b) {
    asm volatile("s_waitcnt vmcnt(0)" ::: "memory");
    __syncthreads();
    if (threadIdx.x == 0) {
        unsigned* bar = b.bar;
        __builtin_amdgcn_s_waitcnt(0);
        unsigned nloc = b.st[0], nx = b.st[1];
        if (nloc == 0u) { xcd_barrier_complete(bar, b.x, nloc, nx); b.st[0] = nloc; b.st[1] = nx; }
        const unsigned old = xb_add(&bar[XB_XSUB(b.x)], 1u);
        const unsigned gen = old / nloc;
        if (old + 1u == (gen + 1u) * nloc) {
            __builtin_amdgcn_fence(__ATOMIC_RELEASE, "agent");
            asm volatile("s_waitcnt vmcnt(0)" ::: "memory");
            const unsigned og = xb_add(&bar[XB_TOP], 1u);
            const unsigned tg = og / nx;
            if (og + 1u == (tg + 1u) * nx) xb_add(&bar[XB_TOPGEN], 1u);
            else XB_SPIN(xb_ld(&bar[XB_TOPGEN]) == tg, bar);
            __builtin_amdgcn_fence(__ATOMIC_ACQUIRE, "agent");
            xb_add(&bar[XB_XGEN(b.x)], 1u);
            asm volatile("s_waitcnt vmcnt(0)" ::: "memory");
        } else {
            XB_SPIN(xb_ld(&bar[XB_XGEN(b.x)]) == gen, bar);
            __builtin_amdgcn_fence(__ATOMIC_ACQUIRE, "agent");
            asm volatile("s_waitcnt vmcnt(0)" ::: "memory");
        }
    }
    __syncthreads();
}

__device__ __forceinline__ void xcd_local_barrier(unsigned* xl, unsigned x) {
    asm volatile("s_waitcnt vmcnt(0)" ::: "memory");
    __syncthreads();
    if (threadIdx.x == 0) {
        __builtin_amdgcn_s_waitcnt(0);
        unsigned* sub = xl + 512 + 64 * x; unsigned* gen = xl + 1024 + 64 * x;
        const unsigned old = xb_add(sub, 1u), g = old / 32u;
        if (old + 1u == (g + 1u) * 32u) (void)xb_add(gen, 1u);
        else { unsigned sp = 0; while (xb_ld(gen) == g) { __builtin_amdgcn_s_sleep(1); if (++sp > (1u << 22)) break; } }
        __builtin_amdgcn_fence(__ATOMIC_ACQUIRE, "agent");
        asm volatile("s_waitcnt vmcnt(0)" ::: "memory");
    }
    __syncthreads();
}

constexpr int N_PHASES = 11;
__global__ void __launch_bounds__(NWAVES * 64, 2) fwd_megakernel(Args args) {
    extern __shared__ __attribute__((aligned(16))) unsigned char lds_raw[];
    LAS unsigned char* lds = (LAS unsigned char*)lds_raw;
    cg::grid_group grid = cg::this_grid();
    const int tid = threadIdx.x, lane = tid & 63, wave = __builtin_amdgcn_readfirstlane(tid >> 6);
    const int G = gridDim.x, bx = blockIdx.x;
    const int gw = bx * NWAVES + wave, NGW = G * NWAVES;
    unsigned char* ws = args.ws;
    float* ss0 = (float*)(ws + WS_SS); float* ss1 = ss0 + M; float* ss2 = ss1 + M; float* ss3 = ss2 + M;
    const int lo = args.ph_lo, hi = args.ph_hi;
    LAS float* rsl = (LAS float*)(lds + RING_BYTES);
    if (tid < 4) ((LAS unsigned*)(lds + LDS_BARW))[tid] = 0u;
    for (unsigned i = (unsigned)(bx * (NWAVES * 64) + tid); i < (unsigned)(CTL_USED_BYTES / 16); i += (unsigned)(G * NWAVES * 64)) ((u32x4*)(ws + WS_CTL))[i] = (u32x4){0u, 0u, 0u, 0u};
    grid.sync();
    const XcdBarrier xbar = xcd_barrier_post((unsigned*)(ws + WS_CTL), (volatile LAS unsigned*)(lds + LDS_BARW));
    unsigned* xl = (unsigned*)(ws + WS_XL);
    const int myx = (int)(xbar.x & 7u);
    if (tid == 0) ((LAS unsigned*)(lds + LDS_BARW))[4] = __hip_atomic_fetch_add(xl + 64 * myx, 1u, __ATOMIC_RELAXED, __HIP_MEMORY_SCOPE_AGENT);
    __syncthreads();
    const int myrank = (int)((volatile LAS unsigned*)(lds + LDS_BARW))[4];
#ifndef PH_MASK
#define PH_MASK 0x7ff
#endif
#define IN(k) (((PH_MASK >> (k)) & 1) && lo <= (k) && (k) < hi)
#define SEAM(k) do { if (IN(k) && IN((k) + 1)) xcd_barrier(xbar); } while (0)
#define LSEAM() do { if (xlmode) xcd_local_barrier(xl, (unsigned)myx); else xcd_barrier(xbar); } while (0)

    if (IN(0)) { p0_prologue(args, lds, gw, NGW, wave, lane); }
    SEAM(0);
    bool xlmode = (G == 256);
#pragma unroll
    for (int x = 0; x < 8; ++x) xlmode = xlmode && (__hip_atomic_load(xl + 64 * x, __ATOMIC_RELAXED, __HIP_MEMORY_SCOPE_AGENT) == 32u);
    const int cu = xlmode ? myrank * 8 + myx : bx;
    unsigned char* actb = ws + WS_ACT + (xlmode ? (size_t)myx * (size_t)(4096 * (NIN - DFF) * 2) : (size_t)0);
    if (IN(1)) {
        pg8::Gemm g{(const bf16_t*)(ws + WS_XB), (const bf16_t*)(ws + WS_W1GU), DM, DM, DM}; pg8::StaticOrder S; S.init(M, NGU, G, cu);
        pg8::EpiSwiGLU E{(bf16_t*)actb, rsl};
        pg8::gemm_phase<pg8::EpiSwiGLU, pg8::StaticOrder, true>(lds, g, S, E, ss0, rsl);
    }
    LSEAM();
    if (IN(2)) {
        pg8::Gemm g{(const bf16_t*)actb, (const bf16_t*)(ws + WS_W1D), DFF, DFF, DFF}; pg8::StaticOrder S; S.init(M, DM, G, cu);
        pg8::EpiResid<true> E{(const void*)(ws + WS_XB), (bf16_t*)(ws + WS_XB), ss1, 0.5f};
        pg8::gemm_phase<pg8::EpiResid<true>, pg8::StaticOrder, true>(lds, g, S, E);
    }
    LSEAM();
    if (IN(3)) {
        pg8::Gemm g{(const bf16_t*)(ws + WS_XB), (const bf16_t*)(ws + WS_WIN), DM, DM, DM}; pg8::StaticOrder S; S.init(M, NIN, G, cu);
        pg8::EpiInProj E{(bf16_t*)(ws + WS_ACT), (float*)(ws + WS_GATES), rsl};
        pg8::gemm_phase<pg8::EpiInProj, pg8::StaticOrder, true>(lds, g, S, E, ss1, rsl);
    }
    LSEAM();
    if (IN(4)) {
        if (xlmode) {
            if (myrank < 24) { const int b = 2 * myx + myrank / 12, rem = myrank % 12; mlstm_state_group(args, lds, b * 4 + rem / 3, rem % 3, tid, wave, lane); }
            for (int k = 0; k < 4; ++k) { const int l = myrank + 32 * k; attn_item(args, lds, ((2 * myx + (l >> 6)) << 6) | (l & 63), tid, wave, lane); }
        } else {
        for (int it = bx; it < 64 * 3; it += G) mlstm_state_group(args, lds, it / 3, it % 3, tid, wave, lane);
        for (int it = bx; it < 1024; it += G) attn_item(args, lds, it, tid, wave, lane);
        }
    }
    LSEAM();
    if (IN(10)) {
        if (xlmode) { const int b = 2 * myx + (myrank >> 4); mlstm_group<false>(args, lds, b * 4 + ((myrank >> 2) & 3), myrank & 3, tid, wave, lane); }
        else for (int it = bx; it < 256; it += G) mlstm_group<false>(args, lds, it >> 2, it & 3, tid, wave, lane);
    }
    LSEAM();
    if (IN(5)) {
        pg8::Gemm g{(const bf16_t*)(ws + WS_HO), (const bf16_t*)(ws + WS_WBR), DM, DM, DM}; pg8::StaticOrder S; S.init(M, DM, G, cu);
        pg8::EpiMerge E{(const bf16_t*)(ws + WS_ACT), (bf16_t*)args.out, 2 * DM};
        pg8::gemm_phase<pg8::EpiMerge, pg8::StaticOrder, true>(lds, g, S, E);
    }
    LSEAM();
    if (IN(6)) {
        pg8::Gemm g{(const bf16_t*)args.out, (const bf16_t*)(ws + WS_WO), 2 * DM, DM, DM}; pg8::StaticOrder S; S.init(M, DM, G, cu);
        pg8::EpiResid<true> E{(const void*)(ws + WS_XB), (bf16_t*)(ws + WS_HO), ss2, 1.0f};
        pg8::gemm_phase<pg8::EpiResid<true>, pg8::StaticOrder, true>(lds, g, S, E);
    }
    LSEAM();
    if (IN(7)) {
        pg8::Gemm g{(const bf16_t*)(ws + WS_HO), (const bf16_t*)(ws + WS_W2GU), DM, DM, DM}; pg8::StaticOrder S; S.init(M, NGU, G, cu);
        pg8::EpiSwiGLU E{(bf16_t*)actb, rsl};
        pg8::gemm_phase<pg8::EpiSwiGLU, pg8::StaticOrder, true>(lds, g, S, E, ss2, rsl);
    }
    LSEAM();
    if (IN(8)) {
        pg8::Gemm g{(const bf16_t*)actb, (const bf16_t*)(ws + WS_W2D), DFF, DFF, DFF}; pg8::StaticOrder S; S.init(M, DM, G, cu);
        pg8::EpiFinal E{(const bf16_t*)(ws + WS_HO), args.out, ss3, (unsigned*)(ws + WS_PCNT), args.gfin, 0.5f};
        pg8::gemm_phase<pg8::EpiFinal, pg8::StaticOrder, true>(lds, g, S, E);
    }
#undef IN
#undef SEAM
}

extern "C" void kernel_launch(void* const* d_in, const int* in_sizes, int n_in, void* d_out, int out_size, void* d_ws, size_t ws_size, hipStream_t stream) {
    static int grid = 0;
    if (grid == 0) {
        if (n_in != 20 || in_sizes[0] != M * DM || out_size != M * DM || ws_size < WS_END) { fprintf(stderr, "kernel_launch: unexpected shapes (n_in %d, in0 %d, out %d, ws %zu)\n", n_in, n_in > 0 ? in_sizes[0] : -1, out_size, ws_size); grid = -1; return; }
        int dev = 0, cus = 0, per_cu = 0;
        if (hipGetDevice(&dev) != hipSuccess || hipDeviceGetAttribute(&cus, hipDeviceAttributeMultiprocessorCount, dev) != hipSuccess) { grid = -1; return; }
        if (hipFuncSetAttribute((const void*)fwd_megakernel, hipFuncAttributeMaxDynamicSharedMemorySize, LDS_BYTES) != hipSuccess) { fprintf(stderr, "kernel_launch: hipFuncSetAttribute failed\n"); grid = -1; return; }
        if (hipOccupancyMaxActiveBlocksPerMultiprocessor(&per_cu, (const void*)fwd_megakernel, NWAVES * 64, LDS_BYTES) != hipSuccess || per_cu < 1) { fprintf(stderr, "kernel_launch: occupancy query gave %d\n", per_cu); (void)hipGetLastError(); grid = -1; return; }
        grid = cus;
    }
    if (grid < 0) return;
    Args a{};
    a.x = (const float*)d_in[0]; a.pos = (const int*)d_in[1];
    a.g1 = (const float*)d_in[2]; a.w1g = (const float*)d_in[3]; a.w1u = (const float*)d_in[4]; a.w1d = (const float*)d_in[5];
    a.gmix = (const float*)d_in[6]; a.win = (const float*)d_in[7]; a.bi = (const float*)d_in[8]; a.bf = (const float*)d_in[9];
    a.gno = (const float*)d_in[10]; a.sinks = (const float*)d_in[11]; a.wbm = (const float*)d_in[12]; a.wba = (const float*)d_in[13]; a.wo = (const float*)d_in[14];
    a.g2 = (const float*)d_in[15]; a.w2g = (const float*)d_in[16]; a.w2u = (const float*)d_in[17]; a.w2d = (const float*)d_in[18]; a.gfin = (const float*)d_in[19];
    a.out = (float*)d_out; a.ws = (unsigned char*)d_ws; a.ph_lo = 0; a.ph_hi = N_PHASES;
    void* kargs[] = {&a};
    hipError_t e = hipLaunchCooperativeKernel((const void*)fwd_megakernel, dim3(grid), dim3(NWAVES * 64), kargs, LDS_BYTES, stream);
    if (e != hipSuccess) fprintf(stderr, "kernel_launch: cooperative launch failed: %s (grid %d)\n", hipGetErrorString(e), grid);
}
```
